# Optimizing an MI355X kernel written in HIP

```python
import math
import jax, jax.numpy as jnp
from jax import lax
import numpy as np

D_MODEL = 1024
BATCH = 4
SEQ = 4096
DEPTH = 4

D_MIX = D_MODEL
H_A = 4
DK_A = 32
DV_A = 64
W_A = H_A * DV_A
H_B = 6
DH_B = 64
W_B = H_B * DH_B
DIL_PATTERNS = ((128, 1), (512, 4), (2048, 16))
H_C = 4
DK_C = 48
DV_C = 96
W_C = H_C * DV_C
SPLIT_SIZES = (H_A * 2 * DK_A, H_A * 2 * DK_A, W_A, W_A,
               W_B, W_B, W_B, W_B,
               H_C * DK_C, H_C * DK_C, W_C, W_C)
IN_COLS = 3712
ROT_THETA = 500000.0
ROT_A = DK_A // 4
ROT_B = DH_B // 4
RET_THETA = 10000.0
Q_BLOCK = 128
RET_CHUNK = 128
EPS = 1e-6
NEG = -1e30

kernel_name = "hymba_diff_dilated_retention_encoder"


def rms_norm(x, g):
    xf = x.astype(jnp.float32)
    y = xf * lax.rsqrt(jnp.mean(xf * xf, axis=-1, keepdims=True) + EPS)
    return y.astype(x.dtype) * g.astype(x.dtype)


def rope(x, theta, rot_dim):
    S = x.shape[1]
    half = rot_dim // 2
    pos = jnp.arange(S, dtype=jnp.float32)
    inv = theta ** (-jnp.arange(0, rot_dim, 2, dtype=jnp.float32) / rot_dim)
    ang = pos[:, None] * inv[None, :]
    shape = (S,) + (1,) * (x.ndim - 3) + (half,)
    cos = jnp.cos(ang).reshape(shape).astype(x.dtype)
    sin = jnp.sin(ang).reshape(shape).astype(x.dtype)
    x1 = x[..., :half]
    x2 = x[..., half:rot_dim]
    return jnp.concatenate([x1 * cos - x2 * sin, x1 * sin + x2 * cos, x[..., rot_dim:]], axis=-1)


def diff_attention(q, k, v, lam, lam_init, subln_g):
    B, S = q.shape[:2]
    nb = S // Q_BLOCK
    scale = DK_A ** -0.5
    qb = q.reshape(B, nb, Q_BLOCK, H_A, 2, DK_A).transpose(1, 0, 2, 3, 4, 5)

    def block(qi):
        s = jnp.einsum('bqhmd,bkhmd->bhmqk', qi, k).astype(jnp.float32) * scale
        p = jax.nn.softmax(s, axis=-1)
        pd = p[:, :, 0] - lam * p[:, :, 1]
        return jnp.einsum('bhqk,bkhd->bqhd', pd.astype(v.dtype), v)

    o = lax.map(block, qb)
    o = o.transpose(1, 0, 2, 3, 4).reshape(B, S, H_A, DV_A)
    return rms_norm(o, subln_g) * (1.0 - lam_init)


def dilated_branch(qb, starts, k, v, offsets):
    S = k.shape[1]
    scale = DH_B ** -0.5

    def block(args):
        qi, start = args
        idx = start + jnp.arange(Q_BLOCK)[:, None] + offsets[None, :]
        valid = (idx >= 0) & (idx < S)
        idx_c = jnp.clip(idx, 0, S - 1)
        kg = k[:, idx_c]
        vg = v[:, idx_c]
        s = jnp.einsum('bqhd,bqjhd->bhqj', qi, kg).astype(jnp.float32) * scale
        s = jnp.where(valid[None, None], s, NEG)
        lse = jax.nn.logsumexp(s, axis=-1)
        p = jnp.exp(s - lse[..., None])
        o = jnp.einsum('bhqj,bqjhd->bqhd', p.astype(v.dtype), vg)
        return o, lse

    return lax.map(block, (qb, starts))


def dilated_attention(q, k, v):
    B, S = q.shape[:2]
    nb = S // Q_BLOCK
    qb = q.reshape(B, nb, Q_BLOCK, H_B, DH_B).transpose(1, 0, 2, 3, 4)
    starts = jnp.arange(nb, dtype=jnp.int32) * Q_BLOCK
    outs, lses = [], []
    for window, dil in DIL_PATTERNS:
        n_side = (window // 2) // dil
        offsets = dil * jnp.arange(-n_side, n_side + 1, dtype=jnp.int32)
        o, lse = dilated_branch(qb, starts, k, v, offsets)
        outs.append(o)
        lses.append(lse)
    o = jnp.stack(outs)
    w = jax.nn.softmax(jnp.stack(lses), axis=0)
    w = w.transpose(0, 1, 2, 4, 3)[..., None].astype(o.dtype)
    o = jnp.sum(w * o, axis=0)
    return o.transpose(1, 0, 2, 3, 4).reshape(B, S, H_B, DH_B)


def retention_scan(q, k, v, log_g, include_diag):
    B, H, S, dk = q.shape
    dv = v.shape[-1]
    C = RET_CHUNK
    N = S // C
    i = jnp.arange(C, dtype=jnp.float32)
    diff = i[:, None] - i[None, :]
    mask = (diff >= 0) if include_diag else (diff > 0)
    lg = log_g[:, None, None]
    d_intra = jnp.where(mask[None], jnp.exp(lg * diff[None]), 0.0)
    q_dec = jnp.exp(log_g[:, None] * (i[None, :] + 1.0))[..., None]
    k_dec = jnp.exp(log_g[:, None] * (C - 1.0 - i[None, :]))[..., None]
    chunk_dec = jnp.exp(log_g * C)[:, None, None]

    def to_chunks(t):
        return t.reshape(B, H, N, C, t.shape[-1]).transpose(2, 0, 1, 3, 4)

    def step(R, xs):
        qc, kc, vc = xs
        att = jnp.einsum('bhid,bhjd->bhij', qc, kc) * d_intra
        inner = jnp.einsum('bhij,bhje->bhie', att, vc)
        cross = jnp.einsum('bhid,bhde->bhie', qc, R) * q_dec
        R = R * chunk_dec + jnp.einsum('bhjd,bhje->bhde', kc * k_dec, vc)
        return R, inner + cross

    R0 = jnp.zeros((B, H, dk, dv), jnp.float32)
    _, o = lax.scan(step, R0, (to_chunks(q), to_chunks(k), to_chunks(v)))
    return o.transpose(1, 2, 0, 3, 4).reshape(B, H, S, dv)


def retention_bidir(q, k, v, decay_logit, gn):
    dt = v.dtype
    qf = q.astype(jnp.float32).transpose(0, 2, 1, 3)
    kf = k.astype(jnp.float32).transpose(0, 2, 1, 3) * (DK_C ** -0.5)
    vf = v.astype(jnp.float32).transpose(0, 2, 1, 3)
    log_g = jax.nn.log_sigmoid(decay_logit.astype(jnp.float32))
    fwd = retention_scan(qf, kf, vf, log_g[0], True)
    bwd = jnp.flip(retention_scan(jnp.flip(qf, 2), jnp.flip(kf, 2), jnp.flip(vf, 2), log_g[1], False), 2)
    o = (fwd + bwd).transpose(0, 2, 1, 3)
    return rms_norm(o, gn).astype(dt)


def setup_inputs(seed: int = 0) -> dict:
    key = jax.random.key(seed)
    ks = jax.random.split(key, 20)
    L, D = DEPTH, D_MODEL
    f32 = jnp.float32
    gamma = 1.0 - 2.0 ** (-jnp.linspace(5.0, 12.0, H_C))
    base_logit = jnp.log(gamma) - jnp.log1p(-gamma)
    return {
        "x": jax.random.normal(ks[0], (BATCH, SEQ, D), f32),
        "c": jax.random.normal(ks[1], (BATCH, D), f32),
        "norm_g": 1.0 + 0.02 * jax.random.normal(ks[2], (L, D), f32),
        "w_ada": 0.5 * D ** -0.5 * jax.random.normal(ks[3], (L, D, 3 * D), f32),
        "b_ada": 0.02 * jax.random.normal(ks[4], (L, 3 * D), f32),
        "w_in": D ** -0.5 * jax.random.normal(ks[5], (L, D, IN_COLS), f32),
        "w_out": D_MIX ** -0.5 * jax.random.normal(ks[6], (L, D_MIX, D), f32),
        "qn_a": 1.0 + 0.02 * jax.random.normal(ks[7], (L, DK_A), f32),
        "kn_a": 1.0 + 0.02 * jax.random.normal(ks[8], (L, DK_A), f32),
        "lambda_q1": 0.1 * jax.random.normal(ks[9], (L, DK_A), f32),
        "lambda_k1": 0.1 * jax.random.normal(ks[10], (L, DK_A), f32),
        "lambda_q2": 0.1 * jax.random.normal(ks[11], (L, DK_A), f32),
        "lambda_k2": 0.1 * jax.random.normal(ks[12], (L, DK_A), f32),
        "subln_a": 1.0 + 0.02 * jax.random.normal(ks[13], (L, DV_A), f32),
        "qn_b": 1.0 + 0.02 * jax.random.normal(ks[14], (L, DH_B), f32),
        "kn_b": 1.0 + 0.02 * jax.random.normal(ks[15], (L, DH_B), f32),
        "ret_decay": base_logit[None, None, :] + 0.1 * jax.random.normal(ks[16], (L, 2, H_C), f32),
        "gn_c": 1.0 + 0.02 * jax.random.normal(ks[17], (L, DV_C), f32),
    }


def reference(x, c, norm_g, w_ada, b_ada, w_in, w_out, qn_a, kn_a, lambda_q1, lambda_k1,
              lambda_q2, lambda_k2, subln_a, qn_b, kn_b, ret_decay, gn_c):
    B, S, _ = x.shape
    split_idx = [int(v) for v in np.cumsum(SPLIT_SIZES)[:-1]]
    cs = jax.nn.silu(c)
    for l in range(DEPTH):
        mod = cs @ w_ada[l] + b_ada[l]
        shift, scale, gate = jnp.split(mod, 3, axis=-1)
        h = rms_norm(x, norm_g[l]) * (1.0 + scale[:, None]) + shift[:, None]
        proj = h @ w_in[l]
        qa, ka, va, ga, qb, kb, vb, gb, qc, kc, vc, gc = jnp.split(proj, split_idx, axis=-1)

        qa = rope(rms_norm(qa.reshape(B, S, H_A, 2, DK_A), qn_a[l]), ROT_THETA, ROT_A)
        ka = rope(rms_norm(ka.reshape(B, S, H_A, 2, DK_A), kn_a[l]), ROT_THETA, ROT_A)
        lam_init = 0.8 - 0.6 * math.exp(-0.3 * l)
        lam = (jnp.exp(jnp.sum(lambda_q1[l] * lambda_k1[l]).astype(jnp.float32))
               - jnp.exp(jnp.sum(lambda_q2[l] * lambda_k2[l]).astype(jnp.float32)) + lam_init)
        oa = diff_attention(qa, ka, va.reshape(B, S, H_A, DV_A), lam, lam_init, subln_a[l])
        oa = oa.reshape(B, S, W_A) * jax.nn.silu(ga)

        qb = rope(rms_norm(qb.reshape(B, S, H_B, DH_B), qn_b[l]), ROT_THETA, ROT_B)
        kb = rope(rms_norm(kb.reshape(B, S, H_B, DH_B), kn_b[l]), ROT_THETA, ROT_B)
        ob = dilated_attention(qb, kb, vb.reshape(B, S, H_B, DH_B))
        ob = ob.reshape(B, S, W_B) * jax.nn.silu(gb)

        qc = rope(qc.reshape(B, S, H_C, DK_C), RET_THETA, DK_C)
        kc = rope(kc.reshape(B, S, H_C, DK_C), RET_THETA, DK_C)
        oc = retention_bidir(qc, kc, vc.reshape(B, S, H_C, DV_C), ret_decay[l], gn_c[l])
        oc = oc.reshape(B, S, W_C) * jax.nn.silu(gc)

        y = jnp.concatenate([oa, ob, oc], axis=-1) @ w_out[l]
        x = x + gate[:, None] * y
    return x
```

```cpp
#include <hip/hip_runtime.h>
#include <hip/hip_cooperative_groups.h>
#include <stdint.h>
#include <stdio.h>
namespace cg = cooperative_groups;

#ifndef REP_G0
#define REP_G0 1
#endif
#ifndef REP_G1
#define REP_G1 1
#endif
#ifndef REP_A
#define REP_A 1
#endif
#ifndef REP_B
#define REP_B 1
#endif
#ifndef REP_C
#define REP_C 1
#endif
#ifndef REP_N
#define REP_N 1
#endif
#ifndef REP_P0
#define REP_P0 1
#endif
#ifndef USE_COOP
#define USE_COOP 1
#endif

typedef unsigned short u16;
typedef short bf16x8 __attribute__((ext_vector_type(8)));
typedef short s16x4 __attribute__((ext_vector_type(4)));
typedef float f32x16 __attribute__((ext_vector_type(16)));
typedef float f32x4 __attribute__((ext_vector_type(4)));
typedef float f32x2 __attribute__((ext_vector_type(2)));
typedef unsigned int u32x4 __attribute__((ext_vector_type(4)));
typedef unsigned int u32x2 __attribute__((ext_vector_type(2)));
typedef __bf16 bf16v2 __attribute__((ext_vector_type(2)));

constexpr int NP = 3840;
constexpr int SEQ = 4096;
constexpr int NTOK = 16384;
constexpr float LOG2E = 1.4426950408889634f;
constexpr int SMEM_BYTES = 73728;

struct Params {
  const float *x, *c, *norm_g, *w_ada, *b_ada, *w_in, *w_out, *qn_a, *kn_a, *lq1, *lk1, *lq2, *lk2,
      *subln_a, *qn_b, *kn_b, *ret_decay, *gn_c;
  float* out;
  u16 *wt_in, *wt_out, *hbuf, *pbuf, *ybuf;
  float *modp, *mod, *rope, *state, *ctab;
  unsigned* bar;
};


template <typename T>
__device__ __forceinline__ void launder(T*& ptr) {
  auto g = (__attribute__((address_space(1))) T*)ptr;
  asm volatile("" : "+s"(g));
  ptr = (T*)g;
}
__device__ __forceinline__ Params opaque_params(const Params& p) {
  Params q = p;
  launder(q.x); launder(q.c); launder(q.norm_g); launder(q.w_ada); launder(q.b_ada); launder(q.w_in); launder(q.w_out);
  launder(q.qn_a); launder(q.kn_a); launder(q.lq1); launder(q.lk1); launder(q.lq2); launder(q.lk2); launder(q.subln_a);
  launder(q.qn_b); launder(q.kn_b); launder(q.ret_decay); launder(q.gn_c); launder(q.out);
  launder(q.wt_in); launder(q.wt_out); launder(q.hbuf); launder(q.pbuf); launder(q.ybuf);
  launder(q.modp); launder(q.mod); launder(q.rope); launder(q.state); launder(q.ctab); launder(q.bar);
  return q;
}

typedef __attribute__((address_space(1))) unsigned long long gu64;
typedef __attribute__((address_space(1))) unsigned int gu32;
__device__ __forceinline__ void store_wt_f32(float* ptr, float v) {
  __hip_atomic_store((gu32*)ptr, __float_as_uint(v), __ATOMIC_RELAXED, __HIP_MEMORY_SCOPE_AGENT);
}

__device__ __forceinline__ size_t toff(size_t row, int k) {
  return ((row >> 1) * 32 + (size_t)(k >> 5)) * 64 + (row & 1) * 32 + (k & 31);
}
__device__ __forceinline__ uint32_t pk2(float a, float b) {
  f32x2 v = {a, b};
  bf16v2 r = __builtin_convertvector(v, bf16v2);
  return __builtin_bit_cast(uint32_t, r);
}
__device__ __forceinline__ float bf_lo(uint32_t u) { return __uint_as_float(u << 16); }
__device__ __forceinline__ float bf_hi(uint32_t u) { return __uint_as_float(u & 0xffff0000u); }
__device__ __forceinline__ float fexp2(float x) { return __builtin_amdgcn_exp2f(x); }
__device__ __forceinline__ float xhalf(float v) { return __shfl_xor(v, 32); }
__device__ __forceinline__ float silu_f(float v) { return v * __builtin_amdgcn_rcpf(1.f + __expf(-v)); }

#define LDSP __attribute__((address_space(3)))
#define RAW_BARRIER() do { asm volatile("s_waitcnt lgkmcnt(0)" ::: "memory"); __builtin_amdgcn_s_barrier(); } while (0)
__device__ __forceinline__ int opaque_tid() {
  int t = threadIdx.x;
  asm volatile("" : "+v"(t));
  return t;
}
__device__ __forceinline__ int opq(int v) {
  asm volatile("" : "+s"(v));
  return v;
}
__device__ __forceinline__ f32x16 mfma32(bf16x8 a, bf16x8 b, f32x16 c) {
  return __builtin_amdgcn_mfma_f32_32x32x16_bf16(a, b, c, 0, 0, 0);
}

__device__ __forceinline__ bf16x8 load_vfrag(const u16* Vs, int pitch, int key0, int d0, int lane) {
  int G = lane >> 4, i = lane & 15;
  int row = key0 + 4 * (G >> 1) + (i >> 2);
  int col = d0 + 16 * (G & 1) + 4 * (i & 3);
  const u16* a0 = Vs + row * pitch + col;
  const u16* a1 = a0 + 8 * pitch;
  s16x4 lo = __builtin_amdgcn_ds_read_tr16_b64_v4i16((__attribute__((address_space(3))) s16x4*)a0);
  s16x4 hi = __builtin_amdgcn_ds_read_tr16_b64_v4i16((__attribute__((address_space(3))) s16x4*)a1);
  bf16x8 r;
  r[0] = lo[0]; r[1] = lo[1]; r[2] = lo[2]; r[3] = lo[3];
  r[4] = hi[0]; r[5] = hi[1]; r[6] = hi[2]; r[7] = hi[3];
  return r;
}

__device__ __forceinline__ bf16x8 pack_p(const f32x16& s, int s2) {
  u32x4 w;
  w[0] = pk2(s[8 * s2 + 0], s[8 * s2 + 1]);
  w[1] = pk2(s[8 * s2 + 2], s[8 * s2 + 3]);
  w[2] = pk2(s[8 * s2 + 4], s[8 * s2 + 5]);
  w[3] = pk2(s[8 * s2 + 6], s[8 * s2 + 7]);
  return __builtin_bit_cast(bf16x8, w);
}

__device__ void phase0(const Params& p_in, char* smem, int bid, int nb) {
  const Params p = opaque_params(p_in);
  const int tid = opaque_tid();
  const int NT_IN = 4 * 16 * 30, NT_OUT = 4 * 16 * 8, NT_ADA = 768, NT_ROPE = 576;
  for (int t = bid; t < NT_IN + NT_OUT + NT_ADA + NT_ROPE; t += nb) {
    if (t < NT_IN + NT_OUT) {
      float* tile = (float*)smem;
      const bool isin = t < NT_IN;
      const int tt = isin ? t : t - NT_IN;
      const int ntn = isin ? 30 : 8;
      const int l = tt / (16 * ntn);
      const int rem = tt % (16 * ntn);
      const int kt = rem / ntn, nt = rem % ntn;
      const int ncols = isin ? 3712 : 1024;
      const float* src = isin ? p.w_in + (size_t)l * 1024 * 3712 : p.w_out + (size_t)l * 1024 * 1024;
      const int np = nt * 128 + (tid & 127);
      int col = np;
      if (isin) {
        if (np >= 3072) col = np - 128;
        else if (np >= 2560) {
          int q = np - 2560;
          int region = q >> 8, hh = (q & 255) >> 6, d = q & 63;
          col = d < 48 ? 2560 + region * 192 + hh * 48 + d : -1;
        }
      }
      const float* sp = src + (size_t)(kt * 64 + (tid >> 7)) * ncols + (col >= 0 ? col : 0);
      float vals[32];
#pragma unroll
      for (int i = 0; i < 32; i++) vals[i] = __builtin_nontemporal_load(sp + (size_t)(2 * i) * ncols);
#pragma unroll
      for (int i = 0; i < 32; i++) tile[(2 * i + (tid >> 7)) * 129 + (tid & 127)] = col >= 0 ? vals[i] : 0.f;
      __syncthreads();
      {
        const int n = tid >> 1, ks = (tid & 1) * 32;
        u16* wbase = isin ? p.wt_in + (size_t)l * NP * 1024 : p.wt_out + (size_t)l * 1024 * 1024;
        const size_t wrow = (size_t)nt * 128 + n;
#pragma unroll
        for (int q4 = 0; q4 < 4; q4++) {
          uint32_t w[4];
#pragma unroll
          for (int j = 0; j < 4; j++)
            w[j] = pk2(tile[(ks + 8 * q4 + 2 * j) * 129 + n], tile[(ks + 8 * q4 + 2 * j + 1) * 129 + n]);
          u32x4 wv = {w[0], w[1], w[2], w[3]};
          *(u32x4*)(wbase + toff(wrow, kt * 64 + ks + 8 * q4)) = wv;
        }
      }
      __syncthreads();
    } else if (t < NT_IN + NT_OUT + NT_ADA) {
      const int tt = t - (NT_IN + NT_OUT);
      const int l = tt / 192;
      const int rem = tt % 192;
      const int cb = rem / 16, kc = rem % 16;
      float* cs = (float*)smem;
      {
        int b = tid >> 6, kk = tid & 63;
        float cv = p.c[b * 1024 + kc * 64 + kk];
        cs[tid] = cv / (1.f + expf(-cv));
      }
      __syncthreads();
      const int col = cb * 256 + tid;
      float a0 = 0.f, a1 = 0.f, a2 = 0.f, a3 = 0.f;
      const float* w = p.w_ada + ((size_t)l * 1024 + kc * 64) * 3072 + col;
#pragma unroll 8
      for (int kk = 0; kk < 64; kk++) {
        float wv = __builtin_nontemporal_load(w + (size_t)kk * 3072);
        a0 += cs[kk] * wv;
        a1 += cs[64 + kk] * wv;
        a2 += cs[128 + kk] * wv;
        a3 += cs[192 + kk] * wv;
      }
      if (kc == 0) {
        float bv = p.b_ada[l * 3072 + col];
        a0 += bv; a1 += bv; a2 += bv; a3 += bv;
      }
      float* mp = p.modp + ((size_t)(kc * 4 + l) * 4) * 3072 + col;
      mp[0] = a0; mp[3072] = a1; mp[2 * 3072] = a2; mp[3 * 3072] = a3;
      __syncthreads();
    } else {
      const int tt = t - (NT_IN + NT_OUT + NT_ADA);
      const int e = tt * 256 + tid;
      if (tt == 0 && tid < 4) {
        const int l = tid;
        float d1 = 0.f, d2 = 0.f, ka = 0.f, kb = 0.f;
        for (int j = 0; j < 32; j++) {
          d1 += p.lq1[l * 32 + j] * p.lk1[l * 32 + j];
          d2 += p.lq2[l * 32 + j] * p.lk2[l * 32 + j];
          ka = fmaxf(ka, fabsf(p.kn_a[l * 32 + j]));
        }
        for (int j = 0; j < 64; j++) kb = fmaxf(kb, fabsf(p.kn_b[l * 64 + j]));
        const float lam_init = 0.8f - 0.6f * expf(-0.3f * (float)l);
        float* ct = p.ctab + l * 16;
        ct[0] = expf(d1) - expf(d2) + lam_init;
        ct[1] = 1.f - lam_init;
        for (int hd = 0; hd < 4; hd++) {
          const float xf = p.ret_decay[(l * 2 + 0) * 4 + hd], xb = p.ret_decay[(l * 2 + 1) * 4 + hd];
          ct[2 + hd] = -log1pf(expf(-xf)) * LOG2E;
          ct[6 + hd] = -log1pf(expf(-xb)) * LOG2E;
        }
        float qa = 0.f;
        for (int j = 0; j < 32; j++) qa = fmaxf(qa, fabsf(p.qn_a[l * 32 + j]));
        ct[10] = ka * 5.656854249492381f * 1.01f;
        ct[12] = qa * 5.656854249492381f * 0.17677669529663687f * LOG2E * 1.01f * ct[10];
        ct[11] = kb * 8.f * 1.01f;
      }
      if (e < 4096 * 36) {
        int pos = e / 36, j = e % 36;
        float expo;
        if (j < 4) expo = -(float)j * (18.931568569324174f / 4.f);
        else if (j < 12) expo = -(float)(j - 4) * (18.931568569324174f / 8.f);
        else expo = -(float)(j - 12) * (13.287712379549449f / 24.f);
        float inv = exp2f(expo);
        float ang = (float)pos * inv;
        double rev = (double)ang * 0.15915494309189535;
        rev -= rint(rev);
        float rf = (float)(rev * 6.283185307179586);
        p.rope[2 * e] = __cosf(rf);
        p.rope[2 * e + 1] = __sinf(rf);
      }
    }
  }
}

__device__ void phase0b(const Params& p_in, int bid, int nb) {
  const Params p = opaque_params(p_in);
  for (int idx = bid * 256 + opaque_tid(); idx < 49152; idx += nb * 256) {
    float s = 0.f;
#pragma unroll
    for (int kc = 0; kc < 16; kc++) s += p.modp[(size_t)kc * 49152 + idx];
    p.mod[idx] = s;
  }
}

__device__ void phase_norm(const Params& p_in, int l, const float* xin, int bid, int nb) {
  const Params p = opaque_params(p_in);
  const int tid = opaque_tid(), wave = tid >> 6, lane = tid & 63;
  for (int grp = bid * 4 + wave; grp < NTOK / 8; grp += nb * 4) {
    const int row0 = grp * 8;
    const int b = row0 >> 12;
    const float* mo = p.mod + (size_t)(l * 4 + b) * 3072;
    const float* g = p.norm_g + l * 1024;
    f32x4 gm[4], sh[4];
#pragma unroll
    for (int i = 0; i < 4; i++) {
      const int col = i * 256 + lane * 4;
      f32x4 gv = *(const f32x4*)(g + col);
      f32x4 sc = *(const f32x4*)(mo + 1024 + col);
      sh[i] = *(const f32x4*)(mo + col);
      gm[i] = gv * (1.f + sc);
    }
#pragma unroll 2
    for (int k = 0; k < 8; k++) {
      const int row = row0 + k;
      const float* xr = xin + (size_t)row * 1024;
      f32x4 v[4];
      float ss = 0.f;
#pragma unroll
      for (int i = 0; i < 4; i++) {
        v[i] = __builtin_nontemporal_load((const f32x4*)(xr + i * 256 + lane * 4));
        ss += v[i][0] * v[i][0] + v[i][1] * v[i][1] + v[i][2] * v[i][2] + v[i][3] * v[i][3];
      }
#pragma unroll
      for (int o = 32; o >= 1; o >>= 1) ss += __shfl_xor(ss, o);
      const float rstd = rsqrtf(ss * (1.f / 1024.f) + 1e-6f);
#pragma unroll
      for (int i = 0; i < 4; i++) {
        const int col = i * 256 + lane * 4;
        f32x4 y = v[i] * rstd * gm[i] + sh[i];
        u32x2 o = {pk2(y[0], y[1]), pk2(y[2], y[3])};
        *(u32x2*)(p.hbuf + toff((size_t)row, col)) = o;
      }
    }
  }
}

template <int MODE>
__device__ void phase_gemm(const Params& p_in, int l, const float* xin, float* outp, char* smem, int bid, int nb) {
  const Params p = opaque_params(p_in);
  const int tid = opaque_tid(), wave = tid >> 6, lane = tid & 63, r = lane & 31, h = lane >> 5;
  const int wm = wave >> 1, wn = wave & 1;
  const u16* A = MODE == 0 ? p.hbuf : p.ybuf;
  const u16* Bt = MODE == 0 ? p.wt_in + (size_t)l * NP * 1024 : p.wt_out + (size_t)l * 1024 * 1024;
  constexpr int NTN = MODE == 0 ? 30 : 8;
  constexpr int ntiles = 64 * NTN;
  const bool xs = (opq(nb) & 7) == 0;
  const int xcd = xs ? (bid & 7) : 0, jl = xs ? (bid >> 3) : bid, nj = xs ? (nb >> 3) : nb;
  const int per_x = xs ? ntiles / 8 : ntiles;
  for (int li = jl; li < per_x; li += nj) {
    int mt, nt;
    if (xs) {
      if (MODE == 0) {
        const int rect = li / 60, within = li % 60;
        mt = 8 * xcd + 4 * (rect >> 1) + (within & 3);
        nt = 15 * ((rect & 1) ^ ((rect >> 1) & 1)) + (within >> 2);
      } else {
        mt = 8 * xcd + (li >> 3);
        nt = li & 7;
      }
    } else {
      mt = li / NTN; nt = li % NTN;
    }
    const int m0 = mt * 256, n0 = nt * 128;
    f32x16 acc[4][2];
#pragma unroll
    for (int a = 0; a < 4; a++)
#pragma unroll
      for (int b2 = 0; b2 < 2; b2++)
#pragma unroll
        for (int i = 0; i < 16; i++) acc[a][b2][i] = 0.f;
    {
      const int i_row = lane >> 2;
      const int cl = (lane & 3) ^ ((i_row >> 2) & 3);
      const u16* gA0 = A + toff((size_t)(m0 + 64 * wave + i_row), cl * 8);
      const u16* gB0 = Bt + toff((size_t)(n0 + 32 * wave + i_row), cl * 8);
      const int physx = (r >> 2) & 3;
      const uint32_t lds_base = (uint32_t)(size_t)(LDSP char*)smem;
      auto issue1 = [&](int kt, int buf, int idx) {
        char* st = smem + buf * 24576;
        if (idx < 4) {
          __builtin_amdgcn_global_load_lds((const unsigned*)(gA0 + kt * 64 + idx * 16384),
                                           (LDSP unsigned*)(st + wave * 4096 + idx * 1024), 16, 0, 0);
        } else {
          __builtin_amdgcn_global_load_lds((const unsigned*)(gB0 + kt * 64 + (idx - 4) * 16384),
                                           (LDSP unsigned*)(st + 16384 + wave * 2048 + (idx - 4) * 1024), 16, 0, 0);
        }
      };
      auto issue = [&](int kt, int buf) {
#pragma unroll
        for (int idx = 0; idx < 6; idx++) issue1(kt, buf, idx);
      };
      asm volatile("s_waitcnt vmcnt(0)" ::: "memory");
      issue(0, 0); issue(1, 1);
      int buf = 0;
      for (int kt = 0; kt < 32; kt++) {
        if (kt < 31) asm volatile("s_waitcnt vmcnt(6)" ::: "memory");
        else asm volatile("s_waitcnt vmcnt(0)" ::: "memory");
        RAW_BARRIER();
        int nb2 = buf + 2; if (nb2 >= 3) nb2 -= 3;
        const bool pf = kt + 2 < 32;
        const uint32_t sta = lds_base + (uint32_t)(buf * 24576);
#pragma unroll
        for (int s2 = 0; s2 < 2; s2++) {
          const uint32_t phys = (uint32_t)(((2 * s2 + h) ^ physx) * 16);
          const uint32_t aaddr = sta + (uint32_t)((wm * 128 + r) * 64) + phys;
          const uint32_t baddr = sta + 16384u + (uint32_t)((wn * 64 + r) * 64) + phys;
          bf16x8 a0, a1, a2, a3, b0, b1;
          asm volatile("ds_read_b128 %0, %1" : "=v"(a0) : "v"(aaddr));
          asm volatile("ds_read_b128 %0, %1" : "=v"(b0) : "v"(baddr));
          asm volatile("ds_read_b128 %0, %1 offset:2048" : "=v"(b1) : "v"(baddr));
          asm volatile("ds_read_b128 %0, %1 offset:2048" : "=v"(a1) : "v"(aaddr));
          asm volatile("ds_read_b128 %0, %1 offset:4096" : "=v"(a2) : "v"(aaddr));
          asm volatile("ds_read_b128 %0, %1 offset:6144" : "=v"(a3) : "v"(aaddr));
          asm volatile("s_waitcnt lgkmcnt(3)" : "+v"(a0), "+v"(b0), "+v"(b1));
          __builtin_amdgcn_s_setprio(1);
          acc[0][0] = mfma32(a0, b0, acc[0][0]);
          acc[0][1] = mfma32(a0, b1, acc[0][1]);
          __builtin_amdgcn_sched_barrier(0);
          if (pf) issue1(kt + 2, nb2, 3 * s2 + 0);
          asm volatile("s_waitcnt lgkmcnt(2)" : "+v"(a1));
          acc[1][0] = mfma32(a1, b0, acc[1][0]);
          acc[1][1] = mfma32(a1, b1, acc[1][1]);
          __builtin_amdgcn_sched_barrier(0);
          if (pf) issue1(kt + 2, nb2, 3 * s2 + 1);
          asm volatile("s_waitcnt lgkmcnt(1)" : "+v"(a2));
          acc[2][0] = mfma32(a2, b0, acc[2][0]);
          acc[2][1] = mfma32(a2, b1, acc[2][1]);
          __builtin_amdgcn_sched_barrier(0);
          if (pf) issue1(kt + 2, nb2, 3 * s2 + 2);
          asm volatile("s_waitcnt lgkmcnt(0)" : "+v"(a3));
          acc[3][0] = mfma32(a3, b0, acc[3][0]);
          acc[3][1] = mfma32(a3, b1, acc[3][1]);
          __builtin_amdgcn_s_setprio(0);
          __builtin_amdgcn_sched_barrier(0);
        }
        buf = buf + 1; if (buf >= 3) buf = 0;
      }
      __syncthreads();
    }
    if (MODE == 1) {
#pragma unroll
      for (int mi = 0; mi < 4; mi++)
#pragma unroll
        for (int ni = 0; ni < 2; ni++) {
          const int col = n0 + wn * 64 + ni * 32 + r;
          const float g = p.mod[(size_t)(l * 4 + (m0 >> 12)) * 3072 + 2048 + col];
          const size_t rbase = (size_t)(m0 + wm * 128 + mi * 32 + 4 * h) * 1024 + col;
          float xo[16];
#pragma unroll
          for (int i = 0; i < 16; i++) xo[i] = xin[rbase + (size_t)((i & 3) + 8 * (i >> 2)) * 1024];
#pragma unroll
          for (int i = 0; i < 16; i++) outp[rbase + (size_t)((i & 3) + 8 * (i >> 2)) * 1024] = xo[i] + g * acc[mi][ni][i];
        }
    } else {
      float* Cw = (float*)smem + wave * (32 * 65);
      const int row = lane & 31, hf = lane >> 5;
#pragma unroll
      for (int mi = 0; mi < 4; mi++) {
#pragma unroll
        for (int ni = 0; ni < 2; ni++)
#pragma unroll
          for (int i = 0; i < 16; i++)
            Cw[((i & 3) + 8 * (i >> 2) + 4 * h) * 65 + ni * 32 + r] = acc[mi][ni][i];
        asm volatile("s_waitcnt lgkmcnt(0)" ::: "memory");
        float v[32];
#pragma unroll
        for (int j = 0; j < 32; j++) v[j] = Cw[row * 65 + hf * 32 + j];
        asm volatile("s_waitcnt lgkmcnt(0)" ::: "memory");
        const int tok = m0 + wm * 128 + mi * 32 + row;
        const int pos = tok & 4095;
        const float* rp = p.rope + (size_t)pos * 72;
        if (n0 < 512) {
          const bool isq = n0 < 256;
          const float* w = (isq ? p.qn_a : p.kn_a) + l * 32;
          const float qs = isq ? 0.17677669529663687f * LOG2E : 1.f;
          float ss = 0.f;
#pragma unroll
          for (int j = 0; j < 32; j++) ss += v[j] * v[j];
          const float rstd = rsqrtf(ss * (1.f / 32.f) + 1e-6f) * qs;
#pragma unroll
          for (int j = 0; j < 32; j++) v[j] = v[j] * rstd * w[j];
#pragma unroll
          for (int j = 0; j < 4; j++) {
            const float cs = rp[2 * j], sn = rp[2 * j + 1];
            const float x1 = v[j], x2 = v[4 + j];
            v[j] = x1 * cs - x2 * sn;
            v[4 + j] = x1 * sn + x2 * cs;
          }
        } else if (n0 >= 1024 && n0 < 1792) {
          const bool isq = n0 < 1408;
          const float* w = (isq ? p.qn_b : p.kn_b) + l * 64 + hf * 32;
          const float qs = isq ? 0.125f * LOG2E : 1.f;
          float ss = 0.f;
#pragma unroll
          for (int j = 0; j < 32; j++) ss += v[j] * v[j];
          ss += xhalf(ss);
          const float rstd = rsqrtf(ss * (1.f / 64.f) + 1e-6f) * qs;
#pragma unroll
          for (int j = 0; j < 32; j++) v[j] = v[j] * rstd * w[j];
          if (hf == 0) {
#pragma unroll
            for (int j = 0; j < 8; j++) {
              const float cs = rp[2 * (4 + j)], sn = rp[2 * (4 + j) + 1];
              const float x1 = v[j], x2 = v[8 + j];
              v[j] = x1 * cs - x2 * sn;
              v[8 + j] = x1 * sn + x2 * cs;
            }
          }
        } else if (n0 >= 2560 && n0 < 3072) {
          const float ksc = n0 >= 2816 ? 0.14433756729740643f : 1.f;
          float xv[16];
#pragma unroll
          for (int k = 0; k < 16; k++) {
            const uint32_t msk = 0u - (uint32_t)hf;
            const uint32_t snd = (__float_as_uint(v[k]) & msk) | (__float_as_uint(v[8 + k]) & ~msk);
            xv[k] = xhalf(__uint_as_float(snd));
          }
          if (hf == 0) {
#pragma unroll
            for (int j = 0; j < 8; j++) {
              const float cs = rp[2 * (12 + j)], sn = rp[2 * (12 + j) + 1];
              const float x1 = v[j], x2 = v[24 + j];
              v[j] = (x1 * cs - x2 * sn) * ksc;
              v[24 + j] = (x1 * sn + x2 * cs) * ksc;
            }
#pragma unroll
            for (int j = 8; j < 24; j++) {
              const float cs = rp[2 * (12 + j)], sn = rp[2 * (12 + j) + 1];
              v[j] = (v[j] * cs - xv[j - 8] * sn) * ksc;
            }
          } else {
#pragma unroll
            for (int k = 0; k < 16; k++) {
              const float cs = rp[2 * (12 + k + 8)], sn = rp[2 * (12 + k + 8) + 1];
              v[k] = (xv[k] * sn + v[k] * cs) * ksc;
            }
          }
        } else if ((n0 >= 768 && n0 < 1024) || (n0 >= 2176 && n0 < 2560) || n0 >= 3456) {
#pragma unroll
          for (int j = 0; j < 32; j++) v[j] = silu_f(v[j]);
        }
        {
          char* Cb = (char*)Cw;
#pragma unroll
          for (int j = 0; j < 4; j++) {
            u32x4 w4 = {pk2(v[8 * j], v[8 * j + 1]), pk2(v[8 * j + 2], v[8 * j + 3]), pk2(v[8 * j + 4], v[8 * j + 5]),
                        pk2(v[8 * j + 6], v[8 * j + 7])};
            *(u32x4*)(Cb + row * 144 + hf * 64 + j * 16) = w4;
          }
          asm volatile("s_waitcnt lgkmcnt(0)" ::: "memory");
          const int rr = lane >> 3, ch = lane & 7;
          u16* dstb = p.pbuf + (size_t)(m0 + wm * 128 + mi * 32 + rr) * NP + n0 + wn * 64 + ch * 8;
#pragma unroll
          for (int ps = 0; ps < 4; ps++) {
            u32x4 w4 = *(const u32x4*)(Cb + (rr + 8 * ps) * 144 + ch * 16);
            *(u32x4*)(dstb + (size_t)(8 * ps) * NP) = w4;
          }
          asm volatile("s_waitcnt lgkmcnt(0)" ::: "memory");
        }
      }
      __syncthreads();
    }
  }
}

template <bool B> struct BoolC { static constexpr bool v = B; };

template <bool SHIFT>
__device__ void attnA_task(const Params& p_in, int l, int task, char* smem) {
  const Params p = opaque_params(p_in);
  const int tid = opaque_tid(), wave = tid >> 6, lane = tid & 63, r = lane & 31, h = lane >> 5;
  const int b = task >> 7, hd = (task >> 5) & 3, qblk = task & 31;
  u16* Ks = (u16*)smem;
  u16* Vs = Ks + 64 * 72;
  const u16* Pb = p.pbuf + (size_t)b * SEQ * NP;
  const int qpos = qblk * 128 + wave * 32 + r;
  bf16x8 qf[2][2];
#pragma unroll
  for (int mp = 0; mp < 2; mp++)
#pragma unroll
    for (int s = 0; s < 2; s++)
      qf[mp][s] = *(const bf16x8*)(Pb + (size_t)qpos * NP + hd * 64 + mp * 32 + s * 16 + h * 8);
  f32x16 O[2][2];
#pragma unroll
  for (int a = 0; a < 2; a++)
#pragma unroll
    for (int c = 0; c < 2; c++)
#pragma unroll
      for (int i = 0; i < 16; i++) O[a][c][i] = 0.f;
  float lsum[2] = {0.f, 0.f};
  float negM[2];
  {
    const float kmax = p.ctab[l * 16 + 10];
#pragma unroll
    for (int mp = 0; mp < 2; mp++) {
      float q2 = 0.f;
#pragma unroll
      for (int s = 0; s < 2; s++)
#pragma unroll
        for (int j = 0; j < 8; j++) {
          float qv = __uint_as_float(((uint32_t)(unsigned short)qf[mp][s][j]) << 16);
          q2 += qv * qv;
        }
      q2 += xhalf(q2);
      negM[mp] = -sqrtf(q2) * kmax;
    }
  }
  bf16x8* Qw = (bf16x8*)(smem + 4 * 64 * 72 * 2) + wave * 256 + lane;
#pragma unroll
  for (int mp = 0; mp < 2; mp++)
#pragma unroll
    for (int s = 0; s < 2; s++) Qw[(mp * 2 + s) * 64] = qf[mp][s];
  const int lrow = tid >> 3, lch = tid & 7;
  u32x4 rk[2], rv[2];
  const u16* gbase = Pb + (size_t)lrow * NP + hd * 64 + lch * 8;
#pragma unroll
  for (int i = 0; i < 2; i++) {
    rk[i] = *(const u32x4*)(gbase + (size_t)(32 * i) * NP + 256);
    rv[i] = *(const u32x4*)(gbase + (size_t)(32 * i) * NP + 512);
  }
#pragma unroll
  for (int i = 0; i < 2; i++) {
    *(u32x4*)(Ks + (lrow + 32 * i) * 72 + lch * 8) = rk[i];
    *(u32x4*)(Vs + (lrow + 32 * i) * 72 + lch * 8) = rv[i];
  }
#pragma unroll
  for (int i = 0; i < 2; i++) {
    rk[i] = *(const u32x4*)(gbase + (size_t)(64 + 32 * i) * NP + 256);
    rv[i] = *(const u32x4*)(gbase + (size_t)(64 + 32 * i) * NP + 512);
  }
  __syncthreads();
  {
  for (int kt = 0; kt < 64; kt++) {
    const u16* Kc = Ks + (kt & 1) * (2 * 64 * 72);
    const u16* Vc = Kc + 64 * 72;
    if (kt + 1 < 64) {
      u16* Kn = Ks + ((kt + 1) & 1) * (2 * 64 * 72);
      u16* Vn = Kn + 64 * 72;
#pragma unroll
      for (int i = 0; i < 2; i++) {
        *(u32x4*)(Kn + (lrow + 32 * i) * 72 + lch * 8) = rk[i];
        *(u32x4*)(Vn + (lrow + 32 * i) * 72 + lch * 8) = rv[i];
      }
    }
    if (kt + 2 < 64) {
#pragma unroll
      for (int i = 0; i < 2; i++) {
        rk[i] = *(const u32x4*)(gbase + (size_t)((kt + 2) * 64 + 32 * i) * NP + 256);
        rv[i] = *(const u32x4*)(gbase + (size_t)((kt + 2) * 64 + 32 * i) * NP + 512);
      }
    }
    auto computeS = [&](int mp, int t2) -> f32x16 {
      f32x16 S;
#pragma unroll
      for (int i = 0; i < 16; i++) S[i] = SHIFT ? negM[mp] : 0.f;
#pragma unroll
      for (int s = 0; s < 2; s++) {
        bf16x8 kf = *(const bf16x8*)(Kc + (t2 * 32 + r) * 72 + mp * 32 + s * 16 + h * 8);
        bf16x8 qfr = Qw[(mp * 2 + s) * 64];
        S = mfma32(kf, qfr, S);
      }
      return S;
    };
    auto doExp = [&](f32x16& S, int mp) {
      float ps = 0.f;
#pragma unroll
      for (int i = 0; i < 16; i++) {
        float pv = fexp2(S[i]);
        ps += pv;
        S[i] = pv;
      }
      lsum[mp] += ps;
    };
    auto doPV = [&](bf16x8 pf0, bf16x8 pf1, int mp, int t2) {
#pragma unroll
      for (int dt = 0; dt < 2; dt++) {
        bf16x8 v0 = load_vfrag(Vc, 72, t2 * 32, dt * 32, lane);
        O[mp][dt] = mfma32(v0, pf0, O[mp][dt]);
        bf16x8 v1 = load_vfrag(Vc, 72, t2 * 32 + 16, dt * 32, lane);
        O[mp][dt] = mfma32(v1, pf1, O[mp][dt]);
      }
    };
    f32x16 Sa = computeS(0, 0);
    f32x16 Sb = computeS(0, 1);
    __builtin_amdgcn_sched_barrier(0);
    doExp(Sa, 0);
    bf16x8 pa0 = pack_p(Sa, 0), pa1 = pack_p(Sa, 1);
    __builtin_amdgcn_sched_barrier(0);
    doPV(pa0, pa1, 0, 0);
    Sa = computeS(1, 0);
    doExp(Sb, 0);
    bf16x8 pb0 = pack_p(Sb, 0), pb1 = pack_p(Sb, 1);
#pragma unroll
    for (int k = 0; k < 6; k++) {
      __builtin_amdgcn_sched_group_barrier(0x8, 1, 0);
      __builtin_amdgcn_sched_group_barrier(0x2, 7, 0);
    }
    __builtin_amdgcn_sched_barrier(0);
    doPV(pb0, pb1, 0, 1);
    Sb = computeS(1, 1);
    doExp(Sa, 1);
    pa0 = pack_p(Sa, 0); pa1 = pack_p(Sa, 1);
#pragma unroll
    for (int k = 0; k < 6; k++) {
      __builtin_amdgcn_sched_group_barrier(0x8, 1, 0);
      __builtin_amdgcn_sched_group_barrier(0x2, 7, 0);
    }
    __builtin_amdgcn_sched_barrier(0);
    doPV(pa0, pa1, 1, 0);
    doExp(Sb, 1);
    pb0 = pack_p(Sb, 0); pb1 = pack_p(Sb, 1);
#pragma unroll
    for (int k = 0; k < 4; k++) {
      __builtin_amdgcn_sched_group_barrier(0x8, 1, 0);
      __builtin_amdgcn_sched_group_barrier(0x2, 10, 0);
    }
    __builtin_amdgcn_sched_barrier(0);
    doPV(pb0, pb1, 1, 1);
    __builtin_amdgcn_sched_barrier(0);
    RAW_BARRIER();
  }
  }
  const float lam = p.ctab[l * 16 + 0];
  const float one_m_li = p.ctab[l * 16 + 1];
  const float l0 = lsum[0] + xhalf(lsum[0]);
  const float l1 = lsum[1] + xhalf(lsum[1]);
  const float inv0 = 1.f / l0, inv1 = lam / l1;
  float ss = 0.f;
#pragma unroll
  for (int dt = 0; dt < 2; dt++)
#pragma unroll
    for (int i = 0; i < 16; i++) {
      float o = O[0][dt][i] * inv0 - O[1][dt][i] * inv1;
      O[0][dt][i] = o;
      ss += o * o;
    }
  ss += xhalf(ss);
  const float rstd = rsqrtf(ss * (1.f / 64.f) + 1e-6f) * one_m_li;
  const size_t tok = (size_t)b * SEQ + qpos;
#pragma unroll
  for (int dt = 0; dt < 2; dt++)
#pragma unroll
    for (int gq = 0; gq < 4; gq++) {
      const int d0 = dt * 32 + 8 * gq + 4 * h;
      u32x2 gt = *(const u32x2*)(p.pbuf + tok * NP + 768 + hd * 64 + d0);
      f32x4 sb = *(const f32x4*)(p.subln_a + l * 64 + d0);
      float v0 = O[0][dt][4 * gq + 0] * rstd * sb[0] * bf_lo(gt[0]);
      float v1 = O[0][dt][4 * gq + 1] * rstd * sb[1] * bf_hi(gt[0]);
      float v2 = O[0][dt][4 * gq + 2] * rstd * sb[2] * bf_lo(gt[1]);
      float v3 = O[0][dt][4 * gq + 3] * rstd * sb[3] * bf_hi(gt[1]);
      u32x2 o = {pk2(v0, v1), pk2(v2, v3)};
      *(u32x2*)(p.ybuf + toff(tok, hd * 64 + d0)) = o;
    }
}

__device__ __forceinline__ void ret_decays(const Params& p, int l, int hd, float& lgf, float& lgb) {
  lgf = p.ctab[l * 16 + 2 + hd];
  lgb = p.ctab[l * 16 + 6 + hd];
}

__device__ __forceinline__ u32x4 scale_bf8(u32x4 v, float sc) {
  u32x4 o;
#pragma unroll
  for (int j = 0; j < 4; j++) o[j] = pk2(bf_lo(v[j]) * sc, bf_hi(v[j]) * sc);
  return o;
}

__device__ void retS_task(const Params& p_in, int l, int task, char* smem) {
  const Params p = opaque_params(p_in);
  const int tid = opaque_tid(), wave = tid >> 6, lane = tid & 63, r = lane & 31, h = lane >> 5;
  const int b = task >> 7, hd = (task >> 5) & 3, n = task & 31;
  u16* Kf = (u16*)smem;
  u16* Kb = Kf + 128 * 72;
  u16* Vs = Kb + 128 * 72;
  const u16* Pb = p.pbuf + ((size_t)b * SEQ + n * 128) * NP;
  float lgf, lgb;
  ret_decays(p, l, hd, lgf, lgb);
#pragma unroll
  for (int i = 0; i < 4; i++) {
    const int c = tid + 256 * i;
    const int row = c >> 3, ch = c & 7;
    u32x4 kv = *(const u32x4*)(Pb + (size_t)row * NP + 2816 + hd * 64 + ch * 8);
    const float df = fexp2(lgf * (float)(127 - row)), db = fexp2(lgb * (float)row);
    *(u32x4*)(Kf + row * 72 + ch * 8) = scale_bf8(kv, df);
    *(u32x4*)(Kb + row * 72 + ch * 8) = scale_bf8(kv, db);
  }
#pragma unroll
  for (int i = 0; i < 6; i++) {
    const int c = tid + 256 * i;
    const int row = c / 12, ch = c % 12;
    *(u32x4*)(Vs + row * 104 + ch * 8) = *(const u32x4*)(Pb + (size_t)row * NP + 3072 + hd * 96 + ch * 8);
  }
  __syncthreads();
  const int dir = wave >> 1, kkt = wave & 1;
  const u16* Kt = dir ? Kb : Kf;
  f32x16 acc[3];
#pragma unroll
  for (int c = 0; c < 3; c++)
#pragma unroll
    for (int i = 0; i < 16; i++) acc[c][i] = 0.f;
#pragma unroll
  for (int s = 0; s < 8; s++) {
    bf16x8 kfr = load_vfrag(Kt, 72, 16 * s, 32 * kkt, lane);
#pragma unroll
    for (int dt = 0; dt < 3; dt++) {
      bf16x8 vfr = load_vfrag(Vs, 104, 16 * s, 32 * dt, lane);
      acc[dt] = mfma32(vfr, kfr, acc[dt]);
    }
  }
  float* dst = p.state + ((((size_t)(b * 4 + hd) * 32 + n) * 2 + dir) * 4608);
  const int kk = 32 * kkt + r;
  if (kk < 48) {
#pragma unroll
    for (int dt = 0; dt < 3; dt++)
#pragma unroll
      for (int i = 0; i < 16; i++) {
        const int d = 32 * dt + (i & 3) + 8 * (i >> 2) + 4 * h;
        store_wt_f32(dst + d * 48 + kk, acc[dt][i]);
      }
  }
}

__device__ void retO_task(const Params& p_in, int l, int task, char* smem) {
  const Params p = opaque_params(p_in);
  const int tid = opaque_tid(), wave = tid >> 6, lane = tid & 63, r = lane & 31, h = lane >> 5;
  const int b = task >> 7, hd = (task >> 5) & 3, qblk = task & 31;
  u16* Ks = (u16*)smem;
  u16* Vs = Ks + 64 * 72;
  u16* RfT = Vs + 64 * 104;
  u16* RbT = RfT + 96 * 72;
  const u16* Pb = p.pbuf + (size_t)b * SEQ * NP;
  const int qpos = qblk * 128 + wave * 32 + r;
  float lgf, lgb;
  ret_decays(p, l, hd, lgf, lgb);
  const float nlgb = -lgb;
  {
    const u16* Pf = (const u16*)(p.state + (size_t)16 * 32 * 2 * 4608) + (((size_t)(b * 4 + hd) * 32 + qblk) * 2) * 4608;
#pragma unroll
    for (int j = 0; j < 3; j++) {
      const int c = tid + 256 * j;
      if (c < 576) {
        const int e = 8 * c;
        const int d = e / 48, kk = e % 48;
        *(u32x4*)(RfT + d * 72 + kk) = *(const u32x4*)(Pf + e);
        *(u32x4*)(RbT + d * 72 + kk) = *(const u32x4*)(Pf + 4608 + e);
      }
    }
  }
  bf16x8 qf[3];
#pragma unroll
  for (int s = 0; s < 3; s++) qf[s] = *(const bf16x8*)(Pb + (size_t)qpos * NP + 2560 + hd * 64 + s * 16 + h * 8);
  f32x16 O[3];
  __syncthreads();
  {
    const int iq = wave * 32 + r;
    const float sf = fexp2(lgf * (float)(iq + 1)), sb = fexp2(lgb * (float)(128 - iq));
#pragma unroll
    for (int dt = 0; dt < 3; dt++) {
      f32x16 X;
#pragma unroll
      for (int i = 0; i < 16; i++) X[i] = 0.f;
#pragma unroll
      for (int s = 0; s < 3; s++) {
        bf16x8 a = *(const bf16x8*)(RfT + (32 * dt + r) * 72 + 16 * s + 8 * h);
        X = mfma32(a, qf[s], X);
      }
#pragma unroll
      for (int i = 0; i < 16; i++) O[dt][i] = X[i] * sf;
#pragma unroll
      for (int i = 0; i < 16; i++) X[i] = 0.f;
#pragma unroll
      for (int s = 0; s < 3; s++) {
        bf16x8 a = *(const bf16x8*)(RbT + (32 * dt + r) * 72 + 16 * s + 8 * h);
        X = mfma32(a, qf[s], X);
      }
#pragma unroll
      for (int i = 0; i < 16; i++) O[dt][i] += X[i] * sb;
    }
  }
  const int krow = tid >> 3, kch = tid & 7;
  u32x4 rk[2], rv[3];
  int vrow[3], vch[3];
#pragma unroll
  for (int i = 0; i < 3; i++) {
    int c = tid + 256 * i;
    vrow[i] = c / 12;
    vch[i] = c % 12;
  }
  const u16* kbase = Pb + (size_t)krow * NP + 2816 + hd * 64 + kch * 8;
  const u16* vbase = Pb + 3072 + hd * 96;
  const int kt0 = 2 * qblk;
#pragma unroll
  for (int i = 0; i < 2; i++) rk[i] = *(const u32x4*)(kbase + (size_t)(kt0 * 64 + 32 * i) * NP);
#pragma unroll
  for (int i = 0; i < 3; i++) rv[i] = *(const u32x4*)(vbase + (size_t)(kt0 * 64 + vrow[i]) * NP + vch[i] * 8);
  for (int kt = kt0; kt < kt0 + 2; kt++) {
    __syncthreads();
#pragma unroll
    for (int i = 0; i < 2; i++) *(u32x4*)(Ks + (krow + 32 * i) * 72 + kch * 8) = rk[i];
#pragma unroll
    for (int i = 0; i < 3; i++) *(u32x4*)(Vs + vrow[i] * 104 + vch[i] * 8) = rv[i];
    __syncthreads();
    if (kt + 1 < kt0 + 2) {
#pragma unroll
      for (int i = 0; i < 2; i++) rk[i] = *(const u32x4*)(kbase + (size_t)((kt + 1) * 64 + 32 * i) * NP);
#pragma unroll
      for (int i = 0; i < 3; i++) rv[i] = *(const u32x4*)(vbase + (size_t)((kt + 1) * 64 + vrow[i]) * NP + vch[i] * 8);
    }
    bf16x8 pf[2][2];
#pragma unroll
    for (int t2 = 0; t2 < 2; t2++) {
      f32x16 S;
#pragma unroll
      for (int i = 0; i < 16; i++) S[i] = 0.f;
#pragma unroll
      for (int s = 0; s < 3; s++) {
        bf16x8 kf = *(const bf16x8*)(Ks + (t2 * 32 + r) * 72 + s * 16 + h * 8);
        S = mfma32(kf, qf[s], S);
      }
      const int kp0 = kt * 64 + t2 * 32 + 4 * h;
#pragma unroll
      for (int i = 0; i < 16; i++) {
        const int kp = kp0 + (i & 3) + 8 * (i >> 2);
        const float delta = (float)(qpos - kp);
        const float e = delta * (delta >= 0.f ? lgf : nlgb);
        S[i] = S[i] * fexp2(e);
      }
      pf[t2][0] = pack_p(S, 0);
      pf[t2][1] = pack_p(S, 1);
    }
#pragma unroll
    for (int t2 = 0; t2 < 2; t2++)
#pragma unroll
      for (int s2 = 0; s2 < 2; s2++)
#pragma unroll
        for (int dt = 0; dt < 3; dt++) {
          bf16x8 vf = load_vfrag(Vs, 104, t2 * 32 + s2 * 16, dt * 32, lane);
          O[dt] = mfma32(vf, pf[t2][s2], O[dt]);
        }
  }
  float ss = 0.f;
#pragma unroll
  for (int dt = 0; dt < 3; dt++)
#pragma unroll
    for (int i = 0; i < 16; i++) ss += O[dt][i] * O[dt][i];
  ss += xhalf(ss);
  const float rstd = rsqrtf(ss * (1.f / 96.f) + 1e-6f);
  const size_t tok = (size_t)b * SEQ + qpos;
#pragma unroll
  for (int dt = 0; dt < 3; dt++)
#pragma unroll
    for (int gq = 0; gq < 4; gq++) {
      const int d0 = dt * 32 + 8 * gq + 4 * h;
      u32x2 gt = *(const u32x2*)(p.pbuf + tok * NP + 3456 + hd * 96 + d0);
      f32x4 gn = *(const f32x4*)(p.gn_c + l * 96 + d0);
      float v0 = O[dt][4 * gq + 0] * rstd * gn[0] * bf_lo(gt[0]);
      float v1 = O[dt][4 * gq + 1] * rstd * gn[1] * bf_hi(gt[0]);
      float v2 = O[dt][4 * gq + 2] * rstd * gn[2] * bf_lo(gt[1]);
      float v3 = O[dt][4 * gq + 3] * rstd * gn[3] * bf_hi(gt[1]);
      u32x2 o = {pk2(v0, v1), pk2(v2, v3)};
      *(u32x2*)(p.ybuf + toff(tok, 640 + hd * 96 + d0)) = o;
    }
}


__device__ void retScan_task(const Params& p_in, int l, int task) {
  const Params p = opaque_params(p_in);
  const int tid = opaque_tid();
  const int half = task & 1, dir = (task >> 1) & 1, pair = task >> 2, hd = pair & 3;
  float lgf, lgb;
  ret_decays(p, l, hd, lgf, lgb);
  const float w = fexp2((dir ? lgb : lgf) * 128.f);
  const float* Sbase = p.state + ((size_t)pair * 32) * 2 * 4608 + (size_t)dir * 4608 + (size_t)half * 2304;
  u16* Pf = (u16*)(p.state + (size_t)16 * 32 * 2 * 4608) + ((size_t)pair * 32) * 2 * 4608 + (size_t)dir * 4608 + (size_t)half * 2304;
  const bool tail = tid < 64;
  f32x4 acc[3];
#pragma unroll
  for (int j = 0; j < 3; j++) acc[j] = (f32x4){0.f, 0.f, 0.f, 0.f};
#pragma unroll 8
  for (int i = 0; i < 32; i++) {
    const int m = dir ? 31 - i : i;
    const f32x4* src = (const f32x4*)(Sbase + (size_t)m * 2 * 4608) + tid;
    u16* dstp = Pf + (size_t)m * 2 * 4608;
#pragma unroll
    for (int j = 0; j < 3; j++) {
      if (j < 2 || tail) {
        f32x4 v = src[256 * j];
        u32x2 x = {pk2(acc[j][0], acc[j][1]), pk2(acc[j][2], acc[j][3])};
        *(u32x2*)(dstp + 4 * (tid + 256 * j)) = x;
        acc[j] = acc[j] * w + v;
      }
    }
  }
}

__device__ __forceinline__ void event_signal(unsigned* cnt) {
  asm volatile("s_waitcnt vmcnt(0)" ::: "memory");
  __syncthreads();
  if (opaque_tid() == 0) {
    (void)__hip_atomic_fetch_add(cnt, 1u, __ATOMIC_RELAXED, __HIP_MEMORY_SCOPE_AGENT);
  }
}
__device__ __forceinline__ void event_wait(unsigned* cnt, unsigned target) {
  if (opaque_tid() == 0) {
    unsigned sp = 0;
    while (__hip_atomic_load(cnt, __ATOMIC_RELAXED, __HIP_MEMORY_SCOPE_AGENT) < target) {
      __builtin_amdgcn_s_sleep(1);
      if (++sp > (1u << 24)) break;
    }
    __builtin_amdgcn_fence(__ATOMIC_ACQUIRE, "agent");
    asm volatile("s_waitcnt vmcnt(0)" ::: "memory");
  }
  __syncthreads();
}

__device__ void attnB_task(const Params& p_in, int l, int task, char* smem) {
  const Params p = opaque_params(p_in);
  const int tid = opaque_tid(), wave = tid >> 6, lane = tid & 63, r = lane & 31, h = lane >> 5;
  const int tblk = task & 1, r16 = (task >> 1) & 15, bh = task >> 5;
  const int b = bh / 6, hd = bh % 6;
  const u16* Pb = p.pbuf + (size_t)b * SEQ * NP;
  const int t0 = tblk * 128 + wave * 32;
  const int pos0 = r16 + 16 * t0;
  const int qpos = pos0 + 16 * r;
  bf16x8 qf[4];
#pragma unroll
  for (int s = 0; s < 4; s++) qf[s] = *(const bf16x8*)(Pb + (size_t)qpos * NP + 1024 + hd * 64 + s * 16 + h * 8);
  f32x16 O[2];
#pragma unroll
  for (int c = 0; c < 2; c++)
#pragma unroll
    for (int i = 0; i < 16; i++) O[c][i] = 0.f;
  float lsum = 0.f;
  float negM;
  {
    float q2 = 0.f;
#pragma unroll
    for (int s = 0; s < 4; s++)
#pragma unroll
      for (int j = 0; j < 8; j++) {
        float qv = __uint_as_float(((uint32_t)(unsigned short)qf[s][j]) << 16);
        q2 += qv * qv;
      }
    q2 += xhalf(q2);
    negM = -sqrtf(q2) * p.ctab[l * 16 + 11];
  }
  bf16x8 kf0[4], kf1[4];
  u32x4 rv0[4], rv1[4];
  auto unit_geom = [&](int u, int& g, int& lo) {
    int uu;
    if (u < 20) { g = 1; uu = u; }
    else if (u < 28) { g = 4; uu = u - 20; }
    else { g = 16; uu = u - 28; }
    lo = pos0 - 64 * g + g * 32 * uu;
  };
  auto prefetch = [&](int u, bf16x8 (&kf)[4], u32x4 (&rv)[4]) {
    int g, lo;
    unit_geom(u, g, lo);
    int kp = lo + g * r;
    kp = kp < 0 ? 0 : (kp > SEQ - 1 ? SEQ - 1 : kp);
    const u16* kb = Pb + (size_t)kp * NP + 1408 + hd * 64 + h * 8;
#pragma unroll
    for (int s = 0; s < 4; s++) kf[s] = *(const bf16x8*)(kb + s * 16);
#pragma unroll
    for (int i = 0; i < 4; i++) {
      int c = lane + 64 * i;
      int row = c >> 3, ch = c & 7;
      int vp = lo + g * row;
      vp = vp < 0 ? 0 : (vp > SEQ - 1 ? SEQ - 1 : vp);
      rv[i] = *(const u32x4*)(Pb + (size_t)vp * NP + 1792 + hd * 64 + ch * 8);
    }
  };
  auto body = [&](int u, bf16x8 (&kf)[4], u32x4 (&rv)[4], u16* Vb) {
    int g, lo;
    unit_geom(u, g, lo);
#pragma unroll
    for (int i = 0; i < 4; i++) {
      int c = lane + 64 * i;
      *(u32x4*)(Vb + (c >> 3) * 72 + (c & 7) * 8) = rv[i];
    }
    f32x16 S;
#pragma unroll
    for (int i = 0; i < 16; i++) S[i] = negM;
#pragma unroll
    for (int s = 0; s < 4; s++) S = mfma32(kf[s], qf[s], S);
    if (u + 2 < 33) prefetch(u + 2, kf, rv);
    const int W = 64 * g;
    const int lob = qpos - W > 0 ? qpos - W : 0;
    const int hib = qpos + W < SEQ - 1 ? qpos + W : SEQ - 1;
    const unsigned rng = (unsigned)(hib - lob);
    const int base = lo + 4 * g * h - lob;
    float ps = 0.f;
#pragma unroll
    for (int i = 0; i < 16; i++) {
      const bool valid = (unsigned)(base + g * ((i & 3) + 8 * (i >> 2))) <= rng;
      float pv = valid ? fexp2(S[i]) : 0.f;
      ps += pv;
      S[i] = pv;
    }
    lsum += ps;
    bf16x8 pf0 = pack_p(S, 0), pf1 = pack_p(S, 1);
    asm volatile("s_waitcnt lgkmcnt(0)" ::: "memory");
#pragma unroll
    for (int dt = 0; dt < 2; dt++) {
      bf16x8 v0 = load_vfrag(Vb, 72, 0, dt * 32, lane);
      O[dt] = mfma32(v0, pf0, O[dt]);
      bf16x8 v1 = load_vfrag(Vb, 72, 16, dt * 32, lane);
      O[dt] = mfma32(v1, pf1, O[dt]);
    }
  };
  u16* Vw0 = (u16*)smem + wave * 2 * 32 * 72;
  u16* Vw1 = Vw0 + 32 * 72;
  prefetch(0, kf0, rv0);
  prefetch(1, kf1, rv1);
  for (int u = 0; u < 33; u += 2) {
    body(u, kf0, rv0, Vw0);
    if (u + 1 < 33) body(u + 1, kf1, rv1, Vw1);
  }
  const float lt = lsum + xhalf(lsum);
  const float inv = 1.f / lt;
  const size_t tok = (size_t)b * SEQ + qpos;
#pragma unroll
  for (int dt = 0; dt < 2; dt++)
#pragma unroll
    for (int gq = 0; gq < 4; gq++) {
      const int d0 = dt * 32 + 8 * gq + 4 * h;
      u32x2 gt = *(const u32x2*)(p.pbuf + tok * NP + 2176 + hd * 64 + d0);
      float v0 = O[dt][4 * gq + 0] * inv * bf_lo(gt[0]);
      float v1 = O[dt][4 * gq + 1] * inv * bf_hi(gt[0]);
      float v2 = O[dt][4 * gq + 2] * inv * bf_lo(gt[1]);
      float v3 = O[dt][4 * gq + 3] * inv * bf_hi(gt[1]);
      u32x2 o = {pk2(v0, v1), pk2(v2, v3)};
      *(u32x2*)(p.ybuf + toff(tok, 256 + hd * 64 + d0)) = o;
    }
}

__device__ void phase_mix(const Params& p, int l, char* smem, int bid, int nb) {
  unsigned* ev = p.bar + 0;
  const bool xs = (opq(nb) & 7) == 0;
  const int xcd = xs ? (bid & 7) : 0, jl = xs ? (bid >> 3) : bid, nj = xs ? (nb >> 3) : nb;
  const int nS = xs ? 64 : 512, nB = xs ? 96 : 768;
  const bool noshiftA = p.ctab[l * 16 + 12] <= 64.f;
  for (int li = jl; li < nS; li += nj) { retS_task(p, l, xcd * nS + li, smem); event_signal(ev); __syncthreads(); }
  unsigned* ev2 = p.bar + 64;
  {
    const int nscan = xs ? 8 : 64;
    const int first = nj - nscan;
    if (jl >= first && jl - first < nscan) {
      event_wait(ev, 512u * (unsigned)(l + 1));
      retScan_task(p, l, xcd * nscan + (jl - first));
      asm volatile("s_waitcnt vmcnt(0)" ::: "memory");
      __syncthreads();
      if (opaque_tid() == 0) {
        __builtin_amdgcn_fence(__ATOMIC_RELEASE, "agent");
        asm volatile("s_waitcnt vmcnt(0)" ::: "memory");
        (void)__hip_atomic_fetch_add(ev2, 1u, __ATOMIC_RELAXED, __HIP_MEMORY_SCOPE_AGENT);
      }
      __syncthreads();
    }
  }
  for (int li = jl; li < nS; li += nj) {
    for (int rep = 0; rep < opq(REP_A); rep++) {
      if (noshiftA) attnA_task<false>(p, l, xcd * nS + li, smem); else attnA_task<true>(p, l, xcd * nS + li, smem);
      __syncthreads();
    }
  }
  for (int li = jl; li < nB; li += nj) {
    for (int rep = 0; rep < opq(REP_B); rep++) { attnB_task(p, l, xcd * nB + li, smem); __syncthreads(); }
  }
  event_wait(ev2, 64u * (unsigned)(l + 1));
  for (int li = jl; li < nS; li += nj) {
    for (int rep = 0; rep < opq(REP_C); rep++) { retO_task(p, l, xcd * nS + li, smem); __syncthreads(); }
  }
}

#define XB_TMO      128
#define XB_XCNT(j)  (256  + 64 * (j))
#define XB_XSUB(j)  (1280 + 64 * (j))
#define XB_XGEN(j)  (2304 + 64 * (j))
#define XB_TOP      3328
#define XB_TOPGEN   3392
#define XCD_BAR_WORDS 3456
#define XB_SPIN_CAP (1u << 22)
#define LAS __attribute__((address_space(3)))
__device__ __forceinline__ unsigned xb_ld(unsigned* p) { return __hip_atomic_load(p, __ATOMIC_RELAXED, __HIP_MEMORY_SCOPE_AGENT); }
__device__ __forceinline__ unsigned xb_add(unsigned* p, unsigned v) { return __hip_atomic_fetch_add(p, v, __ATOMIC_RELAXED, __HIP_MEMORY_SCOPE_AGENT); }
__device__ __forceinline__ unsigned xb_xcc_id() { return (unsigned)__builtin_amdgcn_s_getreg((3 << 11) | 20) & 0xFu; }
#define XB_SPIN(cond, bar) do { unsigned _sp = 0; while (cond) { __builtin_amdgcn_s_sleep(1); \
    if ((++_sp & 255u) == 0u) { if (xb_ld(&(bar)[XB_TMO])) break; if (_sp > XB_SPIN_CAP) { atomicAdd(&(bar)[XB_TMO], 1u); break; } } } } while (0)
struct XcdBarrier { unsigned* bar; unsigned x; volatile LAS unsigned* st; };
__device__ __forceinline__ XcdBarrier xcd_barrier_post(unsigned* bar, volatile LAS unsigned* st) {
  XcdBarrier b; b.bar = bar; b.x = xb_xcc_id(); b.st = st;
  if (opaque_tid() == 0) (void)xb_add(&bar[XB_XCNT(b.x)], 1u);
  return b;
}
__device__ __forceinline__ void xcd_barrier_complete(unsigned* bar, unsigned x, unsigned& nloc, unsigned& nx) {
  const unsigned G = gridDim.x * gridDim.y * gridDim.z;
  unsigned sum, cnt, mine, sp = 0u;
  for (;;) {
    sum = 0u; cnt = 0u; mine = 0u;
#pragma unroll
    for (unsigned j = 0; j < 16; ++j) { const unsigned c = xb_ld(&bar[XB_XCNT(j)]); sum += c; cnt += (c > 0u) ? 1u : 0u; mine = (j == x) ? c : mine; }
    if (sum == G) break;
    __builtin_amdgcn_s_sleep(1);
    if ((++sp & 255u) == 0u) { if (xb_ld(&bar[XB_TMO])) break; if (sp > XB_SPIN_CAP) { atomicAdd(&bar[XB_TMO], 1u); break; } }
  }
  nloc = mine > 0u ? mine : 1u; nx = cnt > 0u ? cnt : 1u;
}
__device__ __forceinline__ void xcd_barrier(const XcdBarrier& b) {
  asm volatile("s_waitcnt vmcnt(0)" ::: "memory");
  __syncthreads();
  if (opaque_tid() == 0) {
    unsigned* bar = b.bar;
    __builtin_amdgcn_s_waitcnt(0);
    unsigned nloc = b.st[0], nx = b.st[1];
    if (nloc == 0u) { xcd_barrier_complete(bar, b.x, nloc, nx); b.st[0] = nloc; b.st[1] = nx; }
    const unsigned old = xb_add(&bar[XB_XSUB(b.x)], 1u);
    const unsigned gen = old / nloc;
    if (old + 1u == (gen + 1u) * nloc) {
      __builtin_amdgcn_fence(__ATOMIC_RELEASE, "agent");
      asm volatile("s_waitcnt vmcnt(0)" ::: "memory");
      const unsigned og = xb_add(&bar[XB_TOP], 1u);
      const unsigned tg = og / nx;
      if (og + 1u == (tg + 1u) * nx) xb_add(&bar[XB_TOPGEN], 1u);
      else XB_SPIN(xb_ld(&bar[XB_TOPGEN]) == tg, bar);
      __builtin_amdgcn_fence(__ATOMIC_ACQUIRE, "agent");
      xb_add(&bar[XB_XGEN(b.x)], 1u);
      asm volatile("s_waitcnt vmcnt(0)" ::: "memory");
    } else {
      XB_SPIN(xb_ld(&bar[XB_XGEN(b.x)]) == gen, bar);
      __builtin_amdgcn_fence(__ATOMIC_ACQUIRE, "agent");
      asm volatile("s_waitcnt vmcnt(0)" ::: "memory");
    }
  }
  __syncthreads();
}

#if USE_COOP
__global__ void __launch_bounds__(256, 2) mega(Params p, int ph_lo, int ph_hi, int coop) {
  __shared__ __attribute__((aligned(16))) char smem[SMEM_BYTES];
  __shared__ uint4 xb_words;
  const int bid = blockIdx.x, nb = gridDim.x;
  if (threadIdx.x == 0) xb_words = make_uint4(0u, 0u, 0u, 0u);
  __syncthreads();
  if (coop) (void)xcd_barrier_post(p.bar, (volatile LAS unsigned*)&xb_words);
  if (ph_hi > 1000) cg::this_grid().sync();
  for (int ph = ph_lo; ph < ph_hi; ph++) {
    if (ph == 0) { for (int rep = 0; rep < opq(REP_P0); rep++) phase0(p, smem, bid, nb); }
    else if (ph == 1) phase0b(p, bid, nb);
    else {
      const int l = (ph - 2) >> 2, sub = (ph - 2) & 3;
      const float* xin = l == 0 ? p.x : p.out;
      if (sub == 0) { for (int rep = 0; rep < opq(REP_N); rep++) phase_norm(p, l, xin, bid, nb); }
      else if (sub == 1) { for (int rep = 0; rep < opq(REP_G0); rep++) phase_gemm<0>(p, l, xin, p.out, smem, bid, nb); }
      else if (sub == 2) phase_mix(p, l, smem, bid, nb);
      else {
        for (int rep = 1; rep < opq(REP_G1); rep++) phase_gemm<1>(p, l, xin, (float*)p.pbuf, smem, bid, nb);
        phase_gemm<1>(p, l, xin, p.out, smem, bid, nb);
      }
    }
    if (coop && ph + 1 < ph_hi) {
      XcdBarrier xb;
      xb.bar = p.bar; xb.x = xb_xcc_id(); xb.st = (volatile LAS unsigned*)&xb_words;
      xcd_barrier(xb);
    }
  }
}
#else
__global__ void __launch_bounds__(256, 2) k_phase0(Params p) {
  __shared__ __attribute__((aligned(16))) char smem[SMEM_BYTES];
  phase0(p, smem, blockIdx.x, gridDim.x);
}
__global__ void __launch_bounds__(256, 2) k_phase0b(Params p) { phase0b(p, blockIdx.x, gridDim.x); }
__global__ void __launch_bounds__(256, 2) k_norm(Params p, int l) {
  phase_norm(p, l, l == 0 ? p.x : p.out, blockIdx.x, gridDim.x);
}
template <int MODE>
__global__ void __launch_bounds__(256, 2) k_gemm(Params p, int l) {
  __shared__ __attribute__((aligned(16))) char smem[SMEM_BYTES];
  phase_gemm<MODE>(p, l, l == 0 ? p.x : p.out, p.out, smem, blockIdx.x, gridDim.x);
}
template <int WHICH>
__global__ void __launch_bounds__(256, WHICH == 0 ? 1 : 2) k_mix(Params p, int l) {
  __shared__ __attribute__((aligned(16))) char smem[SMEM_BYTES];
  if (WHICH == 0) { for (int t = blockIdx.x; t < 512; t += gridDim.x) { attnA_task<true>(p, l, t, smem); __syncthreads(); } }
  if (WHICH == 1) { for (int t = blockIdx.x; t < 512; t += gridDim.x) { retS_task(p, l, t, smem); __syncthreads(); } }
  if (WHICH == 3) { for (int t = blockIdx.x; t < 512; t += gridDim.x) { retO_task(p, l, t, smem); __syncthreads(); } }
  if (WHICH == 2) { for (int t = blockIdx.x; t < 768; t += gridDim.x) { attnB_task(p, l, t, smem); __syncthreads(); } }
}
#endif

extern "C" void kernel_launch(void* const* d_in, const int* in_sizes, int n_in, void* d_out, int out_size,
                              void* d_ws, size_t ws_size, hipStream_t stream) {
  Params p{};
  p.x = (const float*)d_in[0]; p.c = (const float*)d_in[1]; p.norm_g = (const float*)d_in[2];
  p.w_ada = (const float*)d_in[3]; p.b_ada = (const float*)d_in[4]; p.w_in = (const float*)d_in[5];
  p.w_out = (const float*)d_in[6]; p.qn_a = (const float*)d_in[7]; p.kn_a = (const float*)d_in[8];
  p.lq1 = (const float*)d_in[9]; p.lk1 = (const float*)d_in[10]; p.lq2 = (const float*)d_in[11];
  p.lk2 = (const float*)d_in[12]; p.subln_a = (const float*)d_in[13]; p.qn_b = (const float*)d_in[14];
  p.kn_b = (const float*)d_in[15]; p.ret_decay = (const float*)d_in[16]; p.gn_c = (const float*)d_in[17];
  p.out = (float*)d_out;
  char* ws = (char*)d_ws;
  size_t off = 0;
  auto take = [&](size_t bytes) { char* q = ws + off; off += (bytes + 255) & ~(size_t)255; return q; };
  p.wt_in = (u16*)take((size_t)4 * NP * 1024 * 2);
  p.wt_out = (u16*)take((size_t)4 * 1024 * 1024 * 2);
  p.hbuf = (u16*)take((size_t)NTOK * 1024 * 2);
  p.pbuf = (u16*)take((size_t)NTOK * NP * 2);
  p.ybuf = (u16*)take((size_t)NTOK * 1024 * 2);
  p.modp = (float*)take((size_t)16 * 49152 * 4);
  p.mod = (float*)take((size_t)49152 * 4);
  p.rope = (float*)take((size_t)4096 * 72 * 4);
  p.bar = (unsigned*)take((size_t)XCD_BAR_WORDS * 4);
  p.ctab = (float*)take(64 * 4);
  p.state = (float*)p.hbuf;

#if USE_COOP
  static int grid_blocks = 0;
  if (!grid_blocks) {
    int dev = 0, cus = 0, per_cu = 0;
    (void)hipGetDevice(&dev);
    (void)hipDeviceGetAttribute(&cus, hipDeviceAttributeMultiprocessorCount, dev);
    (void)hipOccupancyMaxActiveBlocksPerMultiprocessor(&per_cu, mega, 256, 0);
    if (per_cu < 1) per_cu = 1;
    if (per_cu > 2) per_cu = 2;
    grid_blocks = cus * per_cu;
  }
  (void)hipMemsetAsync(p.bar, 0, (size_t)XCD_BAR_WORDS * 4, stream);
  int lo = 0, hi = 18, coop = 1;
  void* args[] = {&p, &lo, &hi, &coop};
  hipError_t e = hipLaunchCooperativeKernel((void*)mega, dim3(grid_blocks), dim3(256), args, 0, stream);
  if (e != hipSuccess) fprintf(stderr, "cooperative launch failed: %s (grid %d)\n", hipGetErrorString(e), grid_blocks);
#else
  const int G = 512;
  k_phase0<<<G, 256, 0, stream>>>(p);
  k_phase0b<<<G, 256, 0, stream>>>(p);
  for (int l = 0; l < 4; l++) {
    k_norm<<<G, 256, 0, stream>>>(p, l);
    k_gemm<0><<<G, 256, 0, stream>>>(p, l);
    k_mix<0><<<G, 256, 0, stream>>>(p, l);
    k_mix<1><<<G, 256, 0, stream>>>(p, l);
    k_mix<3><<<G, 256, 0, stream>>>(p, l);
    k_mix<2><<<G, 256, 0, stream>>>(p, l);
    k_gemm<1><<<G, 256, 0, stream>>>(p, l);
  }
#endif
}
```

```cpp
#include <hip/hip_runtime.h>
#include <hip/hip_cooperative_groups.h>
#include <stdint.h>
#include <stdio.h>
namespace cg = cooperative_groups;

#ifndef REP_G0
#define REP_G0 1
#endif
#ifndef REP_G1
#define REP_G1 1
#endif
#ifndef REP_A
#define REP_A 1
#endif
#ifndef REP_B
#define REP_B 1
#endif
#ifndef REP_C
#define REP_C 1
#endif
#ifndef REP_N
#define REP_N 1
#endif
#ifndef REP_P0
#define REP_P0 1
#endif
#ifndef USE_COOP
#define USE_COOP 1
#endif

typedef unsigned short u16;
typedef short bf16x8 __attribute__((ext_vector_type(8)));
typedef short s16x4 __attribute__((ext_vector_type(4)));
typedef float f32x16 __attribute__((ext_vector_type(16)));
typedef float f32x4 __attribute__((ext_vector_type(4)));
typedef float f32x2 __attribute__((ext_vector_type(2)));
typedef unsigned int u32x4 __attribute__((ext_vector_type(4)));
typedef unsigned int u32x2 __attribute__((ext_vector_type(2)));
typedef __bf16 bf16v2 __attribute__((ext_vector_type(2)));

constexpr int NP = 3840;
constexpr int SEQ = 4096;
constexpr int NTOK = 16384;
constexpr float LOG2E = 1.4426950408889634f;
constexpr int SMEM_BYTES = 73728;

struct Params {
  const float *x, *c, *norm_g, *w_ada, *b_ada, *w_in, *w_out, *qn_a, *kn_a, *lq1, *lk1, *lq2, *lk2,
      *subln_a, *qn_b, *kn_b, *ret_decay, *gn_c;
  float* out;
  u16 *wt_in, *wt_out, *hbuf, *pbuf, *ybuf;
  float *modp, *mod, *rope, *state, *ctab;
  unsigned* bar;
};


template <typename T>
__device__ __forceinline__ void launder(T*& ptr) {
  auto g = (__attribute__((address_space(1))) T*)ptr;
  asm volatile("" : "+s"(g));
  ptr = (T*)g;
}
__device__ __forceinline__ Params opaque_params(const Params& p) {
  Params q = p;
  launder(q.x); launder(q.c); launder(q.norm_g); launder(q.w_ada); launder(q.b_ada); launder(q.w_in); launder(q.w_out);
  launder(q.qn_a); launder(q.kn_a); launder(q.lq1); launder(q.lk1); launder(q.lq2); launder(q.lk2); launder(q.subln_a);
  launder(q.qn_b); launder(q.kn_b); launder(q.ret_decay); launder(q.gn_c); launder(q.out);
  launder(q.wt_in); launder(q.wt_out); launder(q.hbuf); launder(q.pbuf); launder(q.ybuf);
  launder(q.modp); launder(q.mod); launder(q.rope); launder(q.state); launder(q.ctab); launder(q.bar);
  return q;
}

typedef __attribute__((address_space(1))) unsigned long long gu64;
typedef __attribute__((address_space(1))) unsigned int gu32;
__device__ __forceinline__ void store_wt_f32(float* ptr, float v) {
  __hip_atomic_store((gu32*)ptr, __float_as_uint(v), __ATOMIC_RELAXED, __HIP_MEMORY_SCOPE_AGENT);
}

__device__ __forceinline__ size_t toff(size_t row, int k) {
  return ((row >> 1) * 32 + (size_t)(k >> 5)) * 64 + (row & 1) * 32 + (k & 31);
}
__device__ __forceinline__ uint32_t pk2(float a, float b) {
  f32x2 v = {a, b};
  bf16v2 r = __builtin_convertvector(v, bf16v2);
  return __builtin_bit_cast(uint32_t, r);
}
__device__ __forceinline__ float bf_lo(uint32_t u) { return __uint_as_float(u << 16); }
__device__ __forceinline__ float bf_hi(uint32_t u) { return __uint_as_float(u & 0xffff0000u); }
__device__ __forceinline__ float fexp2(float x) { return __builtin_amdgcn_exp2f(x); }
__device__ __forceinline__ float xhalf(float v) { return __shfl_xor(v, 32); }
__device__ __forceinline__ float silu_f(float v) { return v * __builtin_amdgcn_rcpf(1.f + __expf(-v)); }

#define LDSP __attribute__((address_space(3)))
#define RAW_BARRIER() do { asm volatile("s_waitcnt lgkmcnt(0)" ::: "memory"); __builtin_amdgcn_s_barrier(); } while (0)
__device__ __forceinline__ int opaque_tid() {
  int t = threadIdx.x;
  asm volatile("" : "+v"(t));
  return t;
}
__device__ __forceinline__ int opq(int v) {
  asm volatile("" : "+s"(v));
  return v;
}
__device__ __forceinline__ f32x16 mfma32(bf16x8 a, bf16x8 b, f32x16 c) {
  return __builtin_amdgcn_mfma_f32_32x32x16_bf16(a, b, c, 0, 0, 0);
}

__device__ __forceinline__ bf16x8 load_vfrag(const u16* Vs, int pitch, int key0, int d0, int lane) {
  int G = lane >> 4, i = lane & 15;
  int row = key0 + 4 * (G >> 1) + (i >> 2);
  int col = d0 + 16 * (G & 1) + 4 * (i & 3);
  const u16* a0 = Vs + row * pitch + col;
  const u16* a1 = a0 + 8 * pitch;
  s16x4 lo = __builtin_amdgcn_ds_read_tr16_b64_v4i16((__attribute__((address_space(3))) s16x4*)a0);
  s16x4 hi = __builtin_amdgcn_ds_read_tr16_b64_v4i16((__attribute__((address_space(3))) s16x4*)a1);
  bf16x8 r;
  r[0] = lo[0]; r[1] = lo[1]; r[2] = lo[2]; r[3] = lo[3];
  r[4] = hi[0]; r[5] = hi[1]; r[6] = hi[2]; r[7] = hi[3];
  return r;
}

__device__ __forceinline__ bf16x8 pack_p(const f32x16& s, int s2) {
  u32x4 w;
  w[0] = pk2(s[8 * s2 + 0], s[8 * s2 + 1]);
  w[1] = pk2(s[8 * s2 + 2], s[8 * s2 + 3]);
  w[2] = pk2(s[8 * s2 + 4], s[8 * s2 + 5]);
  w[3] = pk2(s[8 * s2 + 6], s[8 * s2 + 7]);
  return __builtin_bit_cast(bf16x8, w);
}

__device__ void phase0(const Params& p_in, char* smem, int bid, int nb) {
  const Params p = opaque_params(p_in);
  const int tid = opaque_tid();
  const int NT_IN = 4 * 16 * 30, NT_OUT = 4 * 16 * 8, NT_ADA = 768, NT_ROPE = 576;
  for (int t = bid; t < NT_IN + NT_OUT + NT_ADA + NT_ROPE; t += nb) {
    if (t < NT_IN + NT_OUT) {
      float* tile = (float*)smem;
      const bool isin = t < NT_IN;
      const int tt = isin ? t : t - NT_IN;
      const int ntn = isin ? 30 : 8;
      const int l = tt / (16 * ntn);
      const int rem = tt % (16 * ntn);
      const int kt = rem / ntn, nt = rem % ntn;
      const int ncols = isin ? 3712 : 1024;
      const float* src = isin ? p.w_in + (size_t)l * 1024 * 3712 : p.w_out + (size_t)l * 1024 * 1024;
      const int np = nt * 128 + (tid & 127);
      int col = np;
      if (isin) {
        if (np >= 3072) col = np - 128;
        else if (np >= 2560) {
          int q = np - 2560;
          int region = q >> 8, hh = (q & 255) >> 6, d = q & 63;
          col = d < 48 ? 2560 + region * 192 + hh * 48 + d : -1;
        }
      }
      const float* sp = src + (size_t)(kt * 64 + (tid >> 7)) * ncols + (col >= 0 ? col : 0);
      float vals[32];
#pragma unroll
      for (int i = 0; i < 32; i++) vals[i] = __builtin_nontemporal_load(sp + (size_t)(2 * i) * ncols);
#pragma unroll
      for (int i = 0; i < 32; i++) tile[(2 * i + (tid >> 7)) * 129 + (tid & 127)] = col >= 0 ? vals[i] : 0.f;
      __syncthreads();
      {
        const int n = tid >> 1, ks = (tid & 1) * 32;
        u16* wbase = isin ? p.wt_in + (size_t)l * NP * 1024 : p.wt_out + (size_t)l * 1024 * 1024;
        const size_t wrow = (size_t)nt * 128 + n;
#pragma unroll
        for (int q4 = 0; q4 < 4; q4++) {
          uint32_t w[4];
#pragma unroll
          for (int j = 0; j < 4; j++)
            w[j] = pk2(tile[(ks + 8 * q4 + 2 * j) * 129 + n], tile[(ks + 8 * q4 + 2 * j + 1) * 129 + n]);
          u32x4 wv = {w[0], w[1], w[2], w[3]};
          *(u32x4*)(wbase + toff(wrow, kt * 64 + ks + 8 * q4)) = wv;
        }
      }
      __syncthreads();
    } else if (t < NT_IN + NT_OUT + NT_ADA) {
      const int tt = t - (NT_IN + NT_OUT);
      const int l = tt / 192;
      const int rem = tt % 192;
      const int cb = rem / 16, kc = rem % 16;
      float* cs = (float*)smem;
      {
        int b = tid >> 6, kk = tid & 63;
        float cv = p.c[b * 1024 + kc * 64 + kk];
        cs[tid] = cv / (1.f + expf(-cv));
      }
      __syncthreads();
      const int col = cb * 256 + tid;
      float a0 = 0.f, a1 = 0.f, a2 = 0.f, a3 = 0.f;
      const float* w = p.w_ada + ((size_t)l * 1024 + kc * 64) * 3072 + col;
#pragma unroll 8
      for (int kk = 0; kk < 64; kk++) {
        float wv = __builtin_nontemporal_load(w + (size_t)kk * 3072);
        a0 += cs[kk] * wv;
        a1 += cs[64 + kk] * wv;
        a2 += cs[128 + kk] * wv;
        a3 += cs[192 + kk] * wv;
      }
      if (kc == 0) {
        float bv = p.b_ada[l * 3072 + col];
        a0 += bv; a1 += bv; a2 += bv; a3 += bv;
      }
      float* mp = p.modp + ((size_t)(kc * 4 + l) * 4) * 3072 + col;
      mp[0] = a0; mp[3072] = a1; mp[2 * 3072] = a2; mp[3 * 3072] = a3;
      __syncthreads();
    } else {
      const int tt = t - (NT_IN + NT_OUT + NT_ADA);
      const int e = tt * 256 + tid;
      if (tt == 0 && tid < 4) {
        const int l = tid;
        float d1 = 0.f, d2 = 0.f, ka = 0.f, kb = 0.f;
        for (int j = 0; j < 32; j++) {
          d1 += p.lq1[l * 32 + j] * p.lk1[l * 32 + j];
          d2 += p.lq2[l * 32 + j] * p.lk2[l * 32 + j];
          ka = fmaxf(ka, fabsf(p.kn_a[l * 32 + j]));
        }
        for (int j = 0; j < 64; j++) kb = fmaxf(kb, fabsf(p.kn_b[l * 64 + j]));
        const float lam_init = 0.8f - 0.6f * expf(-0.3f * (float)l);
        float* ct = p.ctab + l * 16;
        ct[0] = expf(d1) - expf(d2) + lam_init;
        ct[1] = 1.f - lam_init;
        for (int hd = 0; hd < 4; hd++) {
          const float xf = p.ret_decay[(l * 2 + 0) * 4 + hd], xb = p.ret_decay[(l * 2 + 1) * 4 + hd];
          ct[2 + hd] = -log1pf(expf(-xf)) * LOG2E;
          ct[6 + hd] = -log1pf(expf(-xb)) * LOG2E;
        }
        float qa = 0.f;
        for (int j = 0; j < 32; j++) qa = fmaxf(qa, fabsf(p.qn_a[l * 32 + j]));
        ct[10] = ka * 5.656854249492381f * 1.01f;
        ct[12] = qa * 5.656854249492381f * 0.17677669529663687f * LOG2E * 1.01f * ct[10];
        ct[11] = kb * 8.f * 1.01f;
      }
      if (e < 4096 * 36) {
        int pos = e / 36, j = e % 36;
        float expo;
        if (j < 4) expo = -(float)j * (18.931568569324174f / 4.f);
        else if (j < 12) expo = -(float)(j - 4) * (18.931568569324174f / 8.f);
        else expo = -(float)(j - 12) * (13.287712379549449f / 24.f);
        float inv = exp2f(expo);
        float ang = (float)pos * inv;
        double rev = (double)ang * 0.15915494309189535;
        rev -= rint(rev);
        float rf = (float)(rev * 6.283185307179586);
        p.rope[2 * e] = __cosf(rf);
        p.rope[2 * e + 1] = __sinf(rf);
      }
    }
  }
}

__device__ void phase0b(const Params& p_in, int bid, int nb) {
  const Params p = opaque_params(p_in);
  for (int idx = bid * 256 + opaque_tid(); idx < 49152; idx += nb * 256) {
    float s = 0.f;
#pragma unroll
    for (int kc = 0; kc < 16; kc++) s += p.modp[(size_t)kc * 49152 + idx];
    p.mod[idx] = s;
  }
}

__device__ void phase_norm(const Params& p_in, int l, const float* xin, int bid, int nb) {
  const Params p = opaque_params(p_in);
  const int tid = opaque_tid(), wave = tid >> 6, lane = tid & 63;
  for (int grp = bid * 4 + wave; grp < NTOK / 8; grp += nb * 4) {
    const int row0 = grp * 8;
    const int b = row0 >> 12;
    const float* mo = p.mod + (size_t)(l * 4 + b) * 3072;
    const float* g = p.norm_g + l * 1024;
    f32x4 gm[4], sh[4];
#pragma unroll
    for (int i = 0; i < 4; i++) {
      const int col = i * 256 + lane * 4;
      f32x4 gv = *(const f32x4*)(g + col);
      f32x4 sc = *(const f32x4*)(mo + 1024 + col);
      sh[i] = *(const f32x4*)(mo + col);
      gm[i] = gv * (1.f + sc);
    }
#pragma unroll 2
    for (int k = 0; k < 8; k++) {
      const int row = row0 + k;
      const float* xr = xin + (size_t)row * 1024;
      f32x4 v[4];
      float ss = 0.f;
#pragma unroll
      for (int i = 0; i < 4; i++) {
        v[i] = __builtin_nontemporal_load((const f32x4*)(xr + i * 256 + lane * 4));
        ss += v[i][0] * v[i][0] + v[i][1] * v[i][1] + v[i][2] * v[i][2] + v[i][3] * v[i][3];
      }
#pragma unroll
      for (int o = 32; o >= 1; o >>= 1) ss += __shfl_xor(ss, o);
      const float rstd = rsqrtf(ss * (1.f / 1024.f) + 1e-6f);
#pragma unroll
      for (int i = 0; i < 4; i++) {
        const int col = i * 256 + lane * 4;
        f32x4 y = v[i] * rstd * gm[i] + sh[i];
        u32x2 o = {pk2(y[0], y[1]), pk2(y[2], y[3])};
        *(u32x2*)(p.hbuf + toff((size_t)row, col)) = o;
      }
    }
  }
}

template <int MODE>
__device__ void phase_gemm(const Params& p_in, int l, const float* xin, float* outp, char* smem, int bid, int nb) {
  const Params p = opaque_params(p_in);
  const int tid = opaque_tid(), wave = tid >> 6, lane = tid & 63, r = lane & 31, h = lane >> 5;
  const int wm = wave >> 1, wn = wave & 1;
  const u16* A = MODE == 0 ? p.hbuf : p.ybuf;
  const u16* Bt = MODE == 0 ? p.wt_in + (size_t)l * NP * 1024 : p.wt_out + (size_t)l * 1024 * 1024;
  constexpr int NTN = MODE == 0 ? 30 : 8;
  constexpr int ntiles = 64 * NTN;
  const bool xs = (opq(nb) & 7) == 0;
  const int xcd = xs ? (bid & 7) : 0, jl = xs ? (bid >> 3) : bid, nj = xs ? (nb >> 3) : nb;
  const int per_x = xs ? ntiles / 8 : ntiles;
  for (int li = jl; li < per_x; li += nj) {
    int mt, nt;
    if (xs) {
      if (MODE == 0) {
        const int rect = li / 60, within = li % 60;
        mt = 8 * xcd + 4 * (rect >> 1) + (within & 3);
        nt = 15 * (rect & 1) + (within >> 2);
      } else {
        mt = 8 * xcd + (li >> 3);
        nt = li & 7;
      }
    } else {
      mt = li / NTN; nt = li % NTN;
    }
    const int m0 = mt * 256, n0 = nt * 128;
    f32x16 acc[4][2];
#pragma unroll
    for (int a = 0; a < 4; a++)
#pragma unroll
      for (int b2 = 0; b2 < 2; b2++)
#pragma unroll
        for (int i = 0; i < 16; i++) acc[a][b2][i] = 0.f;
    {
      const int i_row = lane >> 2;
      const int cl = (lane & 3) ^ ((i_row >> 2) & 3);
      const u16* gA0 = A + toff((size_t)(m0 + 64 * wave + i_row), cl * 8);
      const u16* gB0 = Bt + toff((size_t)(n0 + 32 * wave + i_row), cl * 8);
      const int physx = (r >> 2) & 3;
      const uint32_t lds_base = (uint32_t)(size_t)(LDSP char*)smem;
      auto issue1 = [&](int kt, int buf, int idx) {
        char* st = smem + buf * 24576;
        if (idx < 4) {
          __builtin_amdgcn_global_load_lds((const unsigned*)(gA0 + kt * 64 + idx * 16384),
                                           (LDSP unsigned*)(st + wave * 4096 + idx * 1024), 16, 0, 0);
        } else {
          __builtin_amdgcn_global_load_lds((const unsigned*)(gB0 + kt * 64 + (idx - 4) * 16384),
                                           (LDSP unsigned*)(st + 16384 + wave * 2048 + (idx - 4) * 1024), 16, 0, 0);
        }
      };
      auto issue = [&](int kt, int buf) {
#pragma unroll
        for (int idx = 0; idx < 6; idx++) issue1(kt, buf, idx);
      };
      asm volatile("s_waitcnt vmcnt(0)" ::: "memory");
      issue(0, 0); issue(1, 1);
      int buf = 0;
      for (int kt = 0; kt < 32; kt++) {
        if (kt < 31) asm volatile("s_waitcnt vmcnt(6)" ::: "memory");
        else asm volatile("s_waitcnt vmcnt(0)" ::: "memory");
        RAW_BARRIER();
        int nb2 = buf + 2; if (nb2 >= 3) nb2 -= 3;
        const bool pf = kt + 2 < 32;
        const uint32_t sta = lds_base + (uint32_t)(buf * 24576);
#pragma unroll
        for (int s2 = 0; s2 < 2; s2++) {
          const uint32_t phys = (uint32_t)(((2 * s2 + h) ^ physx) * 16);
          const uint32_t aaddr = sta + (uint32_t)((wm * 128 + r) * 64) + phys;
          const uint32_t baddr = sta + 16384u + (uint32_t)((wn * 64 + r) * 64) + phys;
          bf16x8 a0, a1, a2, a3, b0, b1;
          asm volatile("ds_read_b128 %0, %1" : "=v"(a0) : "v"(aaddr));
          asm volatile("ds_read_b128 %0, %1" : "=v"(b0) : "v"(baddr));
          asm volatile("ds_read_b128 %0, %1 offset:2048" : "=v"(b1) : "v"(baddr));
          asm volatile("ds_read_b128 %0, %1 offset:2048" : "=v"(a1) : "v"(aaddr));
          asm volatile("ds_read_b128 %0, %1 offset:4096" : "=v"(a2) : "v"(aaddr));
          asm volatile("ds_read_b128 %0, %1 offset:6144" : "=v"(a3) : "v"(aaddr));
          asm volatile("s_waitcnt lgkmcnt(3)" : "+v"(a0), "+v"(b0), "+v"(b1));
          __builtin_amdgcn_s_setprio(1);
          acc[0][0] = mfma32(a0, b0, acc[0][0]);
          acc[0][1] = mfma32(a0, b1, acc[0][1]);
          __builtin_amdgcn_sched_barrier(0);
          if (pf) issue1(kt + 2, nb2, 3 * s2 + 0);
          asm volatile("s_waitcnt lgkmcnt(2)" : "+v"(a1));
          acc[1][0] = mfma32(a1, b0, acc[1][0]);
          acc[1][1] = mfma32(a1, b1, acc[1][1]);
          __builtin_amdgcn_sched_barrier(0);
          if (pf) issue1(kt + 2, nb2, 3 * s2 + 1);
          asm volatile("s_waitcnt lgkmcnt(1)" : "+v"(a2));
          acc[2][0] = mfma32(a2, b0, acc[2][0]);
          acc[2][1] = mfma32(a2, b1, acc[2][1]);
          __builtin_amdgcn_sched_barrier(0);
          if (pf) issue1(kt + 2, nb2, 3 * s2 + 2);
          asm volatile("s_waitcnt lgkmcnt(0)" : "+v"(a3));
          acc[3][0] = mfma32(a3, b0, acc[3][0]);
          acc[3][1] = mfma32(a3, b1, acc[3][1]);
          __builtin_amdgcn_s_setprio(0);
          __builtin_amdgcn_sched_barrier(0);
        }
        buf = buf + 1; if (buf >= 3) buf = 0;
      }
      __syncthreads();
    }
    if (MODE == 1) {
#pragma unroll
      for (int mi = 0; mi < 4; mi++)
#pragma unroll
        for (int ni = 0; ni < 2; ni++) {
          const int col = n0 + wn * 64 + ni * 32 + r;
          const float g = p.mod[(size_t)(l * 4 + (m0 >> 12)) * 3072 + 2048 + col];
          const size_t rbase = (size_t)(m0 + wm * 128 + mi * 32 + 4 * h) * 1024 + col;
          float xo[16];
#pragma unroll
          for (int i = 0; i < 16; i++) xo[i] = xin[rbase + (size_t)((i & 3) + 8 * (i >> 2)) * 1024];
#pragma unroll
          for (int i = 0; i < 16; i++) outp[rbase + (size_t)((i & 3) + 8 * (i >> 2)) * 1024] = xo[i] + g * acc[mi][ni][i];
        }
    } else {
      float* Cw = (float*)smem + wave * (32 * 65);
      const int row = lane & 31, hf = lane >> 5;
#pragma unroll
      for (int mi = 0; mi < 4; mi++) {
#pragma unroll
        for (int ni = 0; ni < 2; ni++)
#pragma unroll
          for (int i = 0; i < 16; i++)
            Cw[((i & 3) + 8 * (i >> 2) + 4 * h) * 65 + ni * 32 + r] = acc[mi][ni][i];
        asm volatile("s_waitcnt lgkmcnt(0)" ::: "memory");
        float v[32];
#pragma unroll
        for (int j = 0; j < 32; j++) v[j] = Cw[row * 65 + hf * 32 + j];
        asm volatile("s_waitcnt lgkmcnt(0)" ::: "memory");
        const int tok = m0 + wm * 128 + mi * 32 + row;
        const int pos = tok & 4095;
        const float* rp = p.rope + (size_t)pos * 72;
        if (n0 < 512) {
          const bool isq = n0 < 256;
          const float* w = (isq ? p.qn_a : p.kn_a) + l * 32;
          const float qs = isq ? 0.17677669529663687f * LOG2E : 1.f;
          float ss = 0.f;
#pragma unroll
          for (int j = 0; j < 32; j++) ss += v[j] * v[j];
          const float rstd = rsqrtf(ss * (1.f / 32.f) + 1e-6f) * qs;
#pragma unroll
          for (int j = 0; j < 32; j++) v[j] = v[j] * rstd * w[j];
#pragma unroll
          for (int j = 0; j < 4; j++) {
            const float cs = rp[2 * j], sn = rp[2 * j + 1];
            const float x1 = v[j], x2 = v[4 + j];
            v[j] = x1 * cs - x2 * sn;
            v[4 + j] = x1 * sn + x2 * cs;
          }
        } else if (n0 >= 1024 && n0 < 1792) {
          const bool isq = n0 < 1408;
          const float* w = (isq ? p.qn_b : p.kn_b) + l * 64 + hf * 32;
          const float qs = isq ? 0.125f * LOG2E : 1.f;
          float ss = 0.f;
#pragma unroll
          for (int j = 0; j < 32; j++) ss += v[j] * v[j];
          ss += xhalf(ss);
          const float rstd = rsqrtf(ss * (1.f / 64.f) + 1e-6f) * qs;
#pragma unroll
          for (int j = 0; j < 32; j++) v[j] = v[j] * rstd * w[j];
          if (hf == 0) {
#pragma unroll
            for (int j = 0; j < 8; j++) {
              const float cs = rp[2 * (4 + j)], sn = rp[2 * (4 + j) + 1];
              const float x1 = v[j], x2 = v[8 + j];
              v[j] = x1 * cs - x2 * sn;
              v[8 + j] = x1 * sn + x2 * cs;
            }
          }
        } else if (n0 >= 2560 && n0 < 3072) {
          const float ksc = n0 >= 2816 ? 0.14433756729740643f : 1.f;
          float xv[16];
#pragma unroll
          for (int k = 0; k < 16; k++) {
            const uint32_t msk = 0u - (uint32_t)hf;
            const uint32_t snd = (__float_as_uint(v[k]) & msk) | (__float_as_uint(v[8 + k]) & ~msk);
            xv[k] = xhalf(__uint_as_float(snd));
          }
          if (hf == 0) {
#pragma unroll
            for (int j = 0; j < 8; j++) {
              const float cs = rp[2 * (12 + j)], sn = rp[2 * (12 + j) + 1];
              const float x1 = v[j], x2 = v[24 + j];
              v[j] = (x1 * cs - x2 * sn) * ksc;
              v[24 + j] = (x1 * sn + x2 * cs) * ksc;
            }
#pragma unroll
            for (int j = 8; j < 24; j++) {
              const float cs = rp[2 * (12 + j)], sn = rp[2 * (12 + j) + 1];
              v[j] = (v[j] * cs - xv[j - 8] * sn) * ksc;
            }
          } else {
#pragma unroll
            for (int k = 0; k < 16; k++) {
              const float cs = rp[2 * (12 + k + 8)], sn = rp[2 * (12 + k + 8) + 1];
              v[k] = (xv[k] * sn + v[k] * cs) * ksc;
            }
          }
        } else if ((n0 >= 768 && n0 < 1024) || (n0 >= 2176 && n0 < 2560) || n0 >= 3456) {
#pragma unroll
          for (int j = 0; j < 32; j++) v[j] = silu_f(v[j]);
        }
        {
          char* Cb = (char*)Cw;
#pragma unroll
          for (int j = 0; j < 4; j++) {
            u32x4 w4 = {pk2(v[8 * j], v[8 * j + 1]), pk2(v[8 * j + 2], v[8 * j + 3]), pk2(v[8 * j + 4], v[8 * j + 5]),
                        pk2(v[8 * j + 6], v[8 * j + 7])};
            *(u32x4*)(Cb + row * 144 + hf * 64 + j * 16) = w4;
          }
          asm volatile("s_waitcnt lgkmcnt(0)" ::: "memory");
          const int rr = lane >> 3, ch = lane & 7;
          u16* dstb = p.pbuf + (size_t)(m0 + wm * 128 + mi * 32 + rr) * NP + n0 + wn * 64 + ch * 8;
#pragma unroll
          for (int ps = 0; ps < 4; ps++) {
            u32x4 w4 = *(const u32x4*)(Cb + (rr + 8 * ps) * 144 + ch * 16);
            *(u32x4*)(dstb + (size_t)(8 * ps) * NP) = w4;
          }
          asm volatile("s_waitcnt lgkmcnt(0)" ::: "memory");
        }
      }
      __syncthreads();
    }
  }
}

template <bool B> struct BoolC { static constexpr bool v = B; };

template <bool SHIFT>
__device__ void attnA_task(const Params& p_in, int l, int task, char* smem) {
  const Params p = opaque_params(p_in);
  const int tid = opaque_tid(), wave = tid >> 6, lane = tid & 63, r = lane & 31, h = lane >> 5;
  const int b = task >> 7, hd = (task >> 5) & 3, qblk = task & 31;
  u16* Ks = (u16*)smem;
  u16* Vs = Ks + 64 * 72;
  const u16* Pb = p.pbuf + (size_t)b * SEQ * NP;
  const int qpos = qblk * 128 + wave * 32 + r;
  bf16x8 qf[2][2];
#pragma unroll
  for (int mp = 0; mp < 2; mp++)
#pragma unroll
    for (int s = 0; s < 2; s++)
      qf[mp][s] = *(const bf16x8*)(Pb + (size_t)qpos * NP + hd * 64 + mp * 32 + s * 16 + h * 8);
  f32x16 O[2][2];
#pragma unroll
  for (int a = 0; a < 2; a++)
#pragma unroll
    for (int c = 0; c < 2; c++)
#pragma unroll
      for (int i = 0; i < 16; i++) O[a][c][i] = 0.f;
  float lsum[2] = {0.f, 0.f};
  float negM[2];
  {
    const float kmax = p.ctab[l * 16 + 10];
#pragma unroll
    for (int mp = 0; mp < 2; mp++) {
      float q2 = 0.f;
#pragma unroll
      for (int s = 0; s < 2; s++)
#pragma unroll
        for (int j = 0; j < 8; j++) {
          float qv = __uint_as_float(((uint32_t)(unsigned short)qf[mp][s][j]) << 16);
          q2 += qv * qv;
        }
      q2 += xhalf(q2);
      negM[mp] = -sqrtf(q2) * kmax;
    }
  }
  bf16x8* Qw = (bf16x8*)(smem + 4 * 64 * 72 * 2) + wave * 256 + lane;
#pragma unroll
  for (int mp = 0; mp < 2; mp++)
#pragma unroll
    for (int s = 0; s < 2; s++) Qw[(mp * 2 + s) * 64] = qf[mp][s];
  const int lrow = tid >> 3, lch = tid & 7;
  u32x4 rk[2], rv[2];
  const u16* gbase = Pb + (size_t)lrow * NP + hd * 64 + lch * 8;
#pragma unroll
  for (int i = 0; i < 2; i++) {
    rk[i] = *(const u32x4*)(gbase + (size_t)(32 * i) * NP + 256);
    rv[i] = *(const u32x4*)(gbase + (size_t)(32 * i) * NP + 512);
  }
#pragma unroll
  for (int i = 0; i < 2; i++) {
    *(u32x4*)(Ks + (lrow + 32 * i) * 72 + lch * 8) = rk[i];
    *(u32x4*)(Vs + (lrow + 32 * i) * 72 + lch * 8) = rv[i];
  }
#pragma unroll
  for (int i = 0; i < 2; i++) {
    rk[i] = *(const u32x4*)(gbase + (size_t)(64 + 32 * i) * NP + 256);
    rv[i] = *(const u32x4*)(gbase + (size_t)(64 + 32 * i) * NP + 512);
  }
  __syncthreads();
  {
  for (int kt = 0; kt < 64; kt++) {
    const u16* Kc = Ks + (kt & 1) * (2 * 64 * 72);
    const u16* Vc = Kc + 64 * 72;
    if (kt + 1 < 64) {
      u16* Kn = Ks + ((kt + 1) & 1) * (2 * 64 * 72);
      u16* Vn = Kn + 64 * 72;
#pragma unroll
      for (int i = 0; i < 2; i++) {
        *(u32x4*)(Kn + (lrow + 32 * i) * 72 + lch * 8) = rk[i];
        *(u32x4*)(Vn + (lrow + 32 * i) * 72 + lch * 8) = rv[i];
      }
    }
    if (kt + 2 < 64) {
#pragma unroll
      for (int i = 0; i < 2; i++) {
        rk[i] = *(const u32x4*)(gbase + (size_t)((kt + 2) * 64 + 32 * i) * NP + 256);
        rv[i] = *(const u32x4*)(gbase + (size_t)((kt + 2) * 64 + 32 * i) * NP + 512);
      }
    }
    auto computeS = [&](int mp, int t2) -> f32x16 {
      f32x16 S;
#pragma unroll
      for (int i = 0; i < 16; i++) S[i] = SHIFT ? negM[mp] : 0.f;
#pragma unroll
      for (int s = 0; s < 2; s++) {
        bf16x8 kf = *(const bf16x8*)(Kc + (t2 * 32 + r) * 72 + mp * 32 + s * 16 + h * 8);
        S = mfma32(kf, qf[mp][s], S);
      }
      return S;
    };
    auto doExp = [&](f32x16& S, int mp) {
      float ps = 0.f;
#pragma unroll
      for (int i = 0; i < 16; i++) {
        float pv = fexp2(S[i]);
        ps += pv;
        S[i] = pv;
      }
      lsum[mp] += ps;
    };
    auto doPV = [&](bf16x8 pf0, bf16x8 pf1, int mp, int t2) {
#pragma unroll
      for (int dt = 0; dt < 2; dt++) {
        bf16x8 v0 = load_vfrag(Vc, 72, t2 * 32, dt * 32, lane);
        O[mp][dt] = mfma32(v0, pf0, O[mp][dt]);
        bf16x8 v1 = load_vfrag(Vc, 72, t2 * 32 + 16, dt * 32, lane);
        O[mp][dt] = mfma32(v1, pf1, O[mp][dt]);
      }
    };
    f32x16 Sa = computeS(0, 0);
    f32x16 Sb = computeS(0, 1);
    __builtin_amdgcn_sched_barrier(0);
    doExp(Sa, 0);
    bf16x8 pa0 = pack_p(Sa, 0), pa1 = pack_p(Sa, 1);
    __builtin_amdgcn_sched_barrier(0);
    doPV(pa0, pa1, 0, 0);
    Sa = computeS(1, 0);
    doExp(Sb, 0);
    bf16x8 pb0 = pack_p(Sb, 0), pb1 = pack_p(Sb, 1);
#pragma unroll
    for (int k = 0; k < 6; k++) {
      __builtin_amdgcn_sched_group_barrier(0x8, 1, 0);
      __builtin_amdgcn_sched_group_barrier(0x2, 7, 0);
    }
    __builtin_amdgcn_sched_barrier(0);
    doPV(pb0, pb1, 0, 1);
    Sb = computeS(1, 1);
    doExp(Sa, 1);
    pa0 = pack_p(Sa, 0); pa1 = pack_p(Sa, 1);
#pragma unroll
    for (int k = 0; k < 6; k++) {
      __builtin_amdgcn_sched_group_barrier(0x8, 1, 0);
      __builtin_amdgcn_sched_group_barrier(0x2, 7, 0);
    }
    __builtin_amdgcn_sched_barrier(0);
    doPV(pa0, pa1, 1, 0);
    doExp(Sb, 1);
    pb0 = pack_p(Sb, 0); pb1 = pack_p(Sb, 1);
#pragma unroll
    for (int k = 0; k < 4; k++) {
      __builtin_amdgcn_sched_group_barrier(0x8, 1, 0);
      __builtin_amdgcn_sched_group_barrier(0x2, 10, 0);
    }
    __builtin_amdgcn_sched_barrier(0);
    doPV(pb0, pb1, 1, 1);
    __builtin_amdgcn_sched_barrier(0);
    RAW_BARRIER();
  }
  }
  const float lam = p.ctab[l * 16 + 0];
  const float one_m_li = p.ctab[l * 16 + 1];
  const float l0 = lsum[0] + xhalf(lsum[0]);
  const float l1 = lsum[1] + xhalf(lsum[1]);
  const float inv0 = 1.f / l0, inv1 = lam / l1;
  float ss = 0.f;
#pragma unroll
  for (int dt = 0; dt < 2; dt++)
#pragma unroll
    for (int i = 0; i < 16; i++) {
      float o = O[0][dt][i] * inv0 - O[1][dt][i] * inv1;
      O[0][dt][i] = o;
      ss += o * o;
    }
  ss += xhalf(ss);
  const float rstd = rsqrtf(ss * (1.f / 64.f) + 1e-6f) * one_m_li;
  const size_t tok = (size_t)b * SEQ + qpos;
#pragma unroll
  for (int dt = 0; dt < 2; dt++)
#pragma unroll
    for (int gq = 0; gq < 4; gq++) {
      const int d0 = dt * 32 + 8 * gq + 4 * h;
      u32x2 gt = *(const u32x2*)(p.pbuf + tok * NP + 768 + hd * 64 + d0);
      f32x4 sb = *(const f32x4*)(p.subln_a + l * 64 + d0);
      float v0 = O[0][dt][4 * gq + 0] * rstd * sb[0] * bf_lo(gt[0]);
      float v1 = O[0][dt][4 * gq + 1] * rstd * sb[1] * bf_hi(gt[0]);
      float v2 = O[0][dt][4 * gq + 2] * rstd * sb[2] * bf_lo(gt[1]);
      float v3 = O[0][dt][4 * gq + 3] * rstd * sb[3] * bf_hi(gt[1]);
      u32x2 o = {pk2(v0, v1), pk2(v2, v3)};
      *(u32x2*)(p.ybuf + toff(tok, hd * 64 + d0)) = o;
    }
}

__device__ __forceinline__ void ret_decays(const Params& p, int l, int hd, float& lgf, float& lgb) {
  lgf = p.ctab[l * 16 + 2 + hd];
  lgb = p.ctab[l * 16 + 6 + hd];
}

__device__ __forceinline__ u32x4 scale_bf8(u32x4 v, float sc) {
  u32x4 o;
#pragma unroll
  for (int j = 0; j < 4; j++) o[j] = pk2(bf_lo(v[j]) * sc, bf_hi(v[j]) * sc);
  return o;
}

__device__ void retS_task(const Params& p_in, int l, int task, char* smem) {
  const Params p = opaque_params(p_in);
  const int tid = opaque_tid(), wave = tid >> 6, lane = tid & 63, r = lane & 31, h = lane >> 5;
  const int b = task >> 7, hd = (task >> 5) & 3, n = task & 31;
  u16* Kf = (u16*)smem;
  u16* Kb = Kf + 128 * 72;
  u16* Vs = Kb + 128 * 72;
  const u16* Pb = p.pbuf + ((size_t)b * SEQ + n * 128) * NP;
  float lgf, lgb;
  ret_decays(p, l, hd, lgf, lgb);
#pragma unroll
  for (int i = 0; i < 4; i++) {
    const int c = tid + 256 * i;
    const int row = c >> 3, ch = c & 7;
    u32x4 kv = *(const u32x4*)(Pb + (size_t)row * NP + 2816 + hd * 64 + ch * 8);
    const float df = fexp2(lgf * (float)(127 - row)), db = fexp2(lgb * (float)row);
    *(u32x4*)(Kf + row * 72 + ch * 8) = scale_bf8(kv, df);
    *(u32x4*)(Kb + row * 72 + ch * 8) = scale_bf8(kv, db);
  }
#pragma unroll
  for (int i = 0; i < 6; i++) {
    const int c = tid + 256 * i;
    const int row = c / 12, ch = c % 12;
    *(u32x4*)(Vs + row * 104 + ch * 8) = *(const u32x4*)(Pb + (size_t)row * NP + 3072 + hd * 96 + ch * 8);
  }
  __syncthreads();
  const int dir = wave >> 1, kkt = wave & 1;
  const u16* Kt = dir ? Kb : Kf;
  f32x16 acc[3];
#pragma unroll
  for (int c = 0; c < 3; c++)
#pragma unroll
    for (int i = 0; i < 16; i++) acc[c][i] = 0.f;
#pragma unroll
  for (int s = 0; s < 8; s++) {
    bf16x8 kfr = load_vfrag(Kt, 72, 16 * s, 32 * kkt, lane);
#pragma unroll
    for (int dt = 0; dt < 3; dt++) {
      bf16x8 vfr = load_vfrag(Vs, 104, 16 * s, 32 * dt, lane);
      acc[dt] = mfma32(vfr, kfr, acc[dt]);
    }
  }
  float* dst = p.state + ((((size_t)(b * 4 + hd) * 32 + n) * 2 + dir) * 4608);
  const int kk = 32 * kkt + r;
  if (kk < 48) {
#pragma unroll
    for (int dt = 0; dt < 3; dt++)
#pragma unroll
      for (int i = 0; i < 16; i++) {
        const int d = 32 * dt + (i & 3) + 8 * (i >> 2) + 4 * h;
        store_wt_f32(dst + d * 48 + kk, acc[dt][i]);
      }
  }
}

__device__ void retO_task(const Params& p_in, int l, int task, char* smem) {
  const Params p = opaque_params(p_in);
  const int tid = opaque_tid(), wave = tid >> 6, lane = tid & 63, r = lane & 31, h = lane >> 5;
  const int b = task >> 7, hd = (task >> 5) & 3, qblk = task & 31;
  u16* Ks = (u16*)smem;
  u16* Vs = Ks + 64 * 72;
  u16* RfT = Vs + 64 * 104;
  u16* RbT = RfT + 96 * 72;
  const u16* Pb = p.pbuf + (size_t)b * SEQ * NP;
  const int qpos = qblk * 128 + wave * 32 + r;
  float lgf, lgb;
  ret_decays(p, l, hd, lgf, lgb);
  const float nlgb = -lgb;
  {
    const u16* Pf = (const u16*)(p.state + (size_t)16 * 32 * 2 * 4608) + (((size_t)(b * 4 + hd) * 32 + qblk) * 2) * 4608;
#pragma unroll
    for (int j = 0; j < 3; j++) {
      const int c = tid + 256 * j;
      if (c < 576) {
        const int e = 8 * c;
        const int d = e / 48, kk = e % 48;
        *(u32x4*)(RfT + d * 72 + kk) = *(const u32x4*)(Pf + e);
        *(u32x4*)(RbT + d * 72 + kk) = *(const u32x4*)(Pf + 4608 + e);
      }
    }
  }
  bf16x8 qf[3];
#pragma unroll
  for (int s = 0; s < 3; s++) qf[s] = *(const bf16x8*)(Pb + (size_t)qpos * NP + 2560 + hd * 64 + s * 16 + h * 8);
  f32x16 O[3];
  __syncthreads();
  {
    const int iq = wave * 32 + r;
    const float sf = fexp2(lgf * (float)(iq + 1)), sb = fexp2(lgb * (float)(128 - iq));
#pragma unroll
    for (int dt = 0; dt < 3; dt++) {
      f32x16 X;
#pragma unroll
      for (int i = 0; i < 16; i++) X[i] = 0.f;
#pragma unroll
      for (int s = 0; s < 3; s++) {
        bf16x8 a = *(const bf16x8*)(RfT + (32 * dt + r) * 72 + 16 * s + 8 * h);
        X = mfma32(a, qf[s], X);
      }
#pragma unroll
      for (int i = 0; i < 16; i++) O[dt][i] = X[i] * sf;
#pragma unroll
      for (int i = 0; i < 16; i++) X[i] = 0.f;
#pragma unroll
      for (int s = 0; s < 3; s++) {
        bf16x8 a = *(const bf16x8*)(RbT + (32 * dt + r) * 72 + 16 * s + 8 * h);
        X = mfma32(a, qf[s], X);
      }
#pragma unroll
      for (int i = 0; i < 16; i++) O[dt][i] += X[i] * sb;
    }
  }
  const int krow = tid >> 3, kch = tid & 7;
  u32x4 rk[2], rv[3];
  int vrow[3], vch[3];
#pragma unroll
  for (int i = 0; i < 3; i++) {
    int c = tid + 256 * i;
    vrow[i] = c / 12;
    vch[i] = c % 12;
  }
  const u16* kbase = Pb + (size_t)krow * NP + 2816 + hd * 64 + kch * 8;
  const u16* vbase = Pb + 3072 + hd * 96;
  const int kt0 = 2 * qblk;
#pragma unroll
  for (int i = 0; i < 2; i++) rk[i] = *(const u32x4*)(kbase + (size_t)(kt0 * 64 + 32 * i) * NP);
#pragma unroll
  for (int i = 0; i < 3; i++) rv[i] = *(const u32x4*)(vbase + (size_t)(kt0 * 64 + vrow[i]) * NP + vch[i] * 8);
  for (int kt = kt0; kt < kt0 + 2; kt++) {
    __syncthreads();
#pragma unroll
    for (int i = 0; i < 2; i++) *(u32x4*)(Ks + (krow + 32 * i) * 72 + kch * 8) = rk[i];
#pragma unroll
    for (int i = 0; i < 3; i++) *(u32x4*)(Vs + vrow[i] * 104 + vch[i] * 8) = rv[i];
    __syncthreads();
    if (kt + 1 < kt0 + 2) {
#pragma unroll
      for (int i = 0; i < 2; i++) rk[i] = *(const u32x4*)(kbase + (size_t)((kt + 1) * 64 + 32 * i) * NP);
#pragma unroll
      for (int i = 0; i < 3; i++) rv[i] = *(const u32x4*)(vbase + (size_t)((kt + 1) * 64 + vrow[i]) * NP + vch[i] * 8);
    }
    bf16x8 pf[2][2];
#pragma unroll
    for (int t2 = 0; t2 < 2; t2++) {
      f32x16 S;
#pragma unroll
      for (int i = 0; i < 16; i++) S[i] = 0.f;
#pragma unroll
      for (int s = 0; s < 3; s++) {
        bf16x8 kf = *(const bf16x8*)(Ks + (t2 * 32 + r) * 72 + s * 16 + h * 8);
        S = mfma32(kf, qf[s], S);
      }
      const int kp0 = kt * 64 + t2 * 32 + 4 * h;
#pragma unroll
      for (int i = 0; i < 16; i++) {
        const int kp = kp0 + (i & 3) + 8 * (i >> 2);
        const float delta = (float)(qpos - kp);
        const float e = delta * (delta >= 0.f ? lgf : nlgb);
        S[i] = S[i] * fexp2(e);
      }
      pf[t2][0] = pack_p(S, 0);
      pf[t2][1] = pack_p(S, 1);
    }
#pragma unroll
    for (int t2 = 0; t2 < 2; t2++)
#pragma unroll
      for (int s2 = 0; s2 < 2; s2++)
#pragma unroll
        for (int dt = 0; dt < 3; dt++) {
          bf16x8 vf = load_vfrag(Vs, 104, t2 * 32 + s2 * 16, dt * 32, lane);
          O[dt] = mfma32(vf, pf[t2][s2], O[dt]);
        }
  }
  float ss = 0.f;
#pragma unroll
  for (int dt = 0; dt < 3; dt++)
#pragma unroll
    for (int i = 0; i < 16; i++) ss += O[dt][i] * O[dt][i];
  ss += xhalf(ss);
  const float rstd = rsqrtf(ss * (1.f / 96.f) + 1e-6f);
  const size_t tok = (size_t)b * SEQ + qpos;
#pragma unroll
  for (int dt = 0; dt < 3; dt++)
#pragma unroll
    for (int gq = 0; gq < 4; gq++) {
      const int d0 = dt * 32 + 8 * gq + 4 * h;
      u32x2 gt = *(const u32x2*)(p.pbuf + tok * NP + 3456 + hd * 96 + d0);
      f32x4 gn = *(const f32x4*)(p.gn_c + l * 96 + d0);
      float v0 = O[dt][4 * gq + 0] * rstd * gn[0] * bf_lo(gt[0]);
      float v1 = O[dt][4 * gq + 1] * rstd * gn[1] * bf_hi(gt[0]);
      float v2 = O[dt][4 * gq + 2] * rstd * gn[2] * bf_lo(gt[1]);
      float v3 = O[dt][4 * gq + 3] * rstd * gn[3] * bf_hi(gt[1]);
      u32x2 o = {pk2(v0, v1), pk2(v2, v3)};
      *(u32x2*)(p.ybuf + toff(tok, 640 + hd * 96 + d0)) = o;
    }
}


__device__ void retScan_task(const Params& p_in, int l, int task) {
  const Params p = opaque_params(p_in);
  const int tid = opaque_tid();
  const int half = task & 1, dir = (task >> 1) & 1, pair = task >> 2, hd = pair & 3;
  float lgf, lgb;
  ret_decays(p, l, hd, lgf, lgb);
  const float w = fexp2((dir ? lgb : lgf) * 128.f);
  const float* Sbase = p.state + ((size_t)pair * 32) * 2 * 4608 + (size_t)dir * 4608 + (size_t)half * 2304;
  u16* Pf = (u16*)(p.state + (size_t)16 * 32 * 2 * 4608) + ((size_t)pair * 32) * 2 * 4608 + (size_t)dir * 4608 + (size_t)half * 2304;
  const bool tail = tid < 64;
  f32x4 acc[3];
#pragma unroll
  for (int j = 0; j < 3; j++) acc[j] = (f32x4){0.f, 0.f, 0.f, 0.f};
#pragma unroll 8
  for (int i = 0; i < 32; i++) {
    const int m = dir ? 31 - i : i;
    const f32x4* src = (const f32x4*)(Sbase + (size_t)m * 2 * 4608) + tid;
    u16* dstp = Pf + (size_t)m * 2 * 4608;
#pragma unroll
    for (int j = 0; j < 3; j++) {
      if (j < 2 || tail) {
        f32x4 v = src[256 * j];
        u32x2 x = {pk2(acc[j][0], acc[j][1]), pk2(acc[j][2], acc[j][3])};
        *(u32x2*)(dstp + 4 * (tid + 256 * j)) = x;
        acc[j] = acc[j] * w + v;
      }
    }
  }
}

__device__ __forceinline__ void event_signal(unsigned* cnt) {
  asm volatile("s_waitcnt vmcnt(0)" ::: "memory");
  __syncthreads();
  if (opaque_tid() == 0) {
    (void)__hip_atomic_fetch_add(cnt, 1u, __ATOMIC_RELAXED, __HIP_MEMORY_SCOPE_AGENT);
  }
}
__device__ __forceinline__ void event_wait(unsigned* cnt, unsigned target) {
  if (opaque_tid() == 0) {
    unsigned sp = 0;
    while (__hip_atomic_load(cnt, __ATOMIC_RELAXED, __HIP_MEMORY_SCOPE_AGENT) < target) {
      __builtin_amdgcn_s_sleep(1);
      if (++sp > (1u << 24)) break;
    }
    __builtin_amdgcn_fence(__ATOMIC_ACQUIRE, "agent");
    asm volatile("s_waitcnt vmcnt(0)" ::: "memory");
  }
  __syncthreads();
}

__device__ void attnB_task(const Params& p_in, int l, int task, char* smem) {
  const Params p = opaque_params(p_in);
  const int tid = opaque_tid(), wave = tid >> 6, lane = tid & 63, r = lane & 31, h = lane >> 5;
  const int tblk = task & 1, r16 = (task >> 1) & 15, bh = task >> 5;
  const int b = bh / 6, hd = bh % 6;
  const u16* Pb = p.pbuf + (size_t)b * SEQ * NP;
  const int t0 = tblk * 128 + wave * 32;
  const int pos0 = r16 + 16 * t0;
  const int qpos = pos0 + 16 * r;
  bf16x8 qf[4];
#pragma unroll
  for (int s = 0; s < 4; s++) qf[s] = *(const bf16x8*)(Pb + (size_t)qpos * NP + 1024 + hd * 64 + s * 16 + h * 8);
  f32x16 O[2];
#pragma unroll
  for (int c = 0; c < 2; c++)
#pragma unroll
    for (int i = 0; i < 16; i++) O[c][i] = 0.f;
  float lsum = 0.f;
  float negM;
  {
    float q2 = 0.f;
#pragma unroll
    for (int s = 0; s < 4; s++)
#pragma unroll
      for (int j = 0; j < 8; j++) {
        float qv = __uint_as_float(((uint32_t)(unsigned short)qf[s][j]) << 16);
        q2 += qv * qv;
      }
    q2 += xhalf(q2);
    negM = -sqrtf(q2) * p.ctab[l * 16 + 11];
  }
  bf16x8 kf0[4], kf1[4];
  u32x4 rv0[4], rv1[4];
  auto unit_geom = [&](int u, int& g, int& lo) {
    int uu;
    if (u < 20) { g = 1; uu = u; }
    else if (u < 28) { g = 4; uu = u - 20; }
    else { g = 16; uu = u - 28; }
    lo = pos0 - 64 * g + g * 32 * uu;
  };
  auto prefetch = [&](int u, bf16x8 (&kf)[4], u32x4 (&rv)[4]) {
    int g, lo;
    unit_geom(u, g, lo);
    int kp = lo + g * r;
    kp = kp < 0 ? 0 : (kp > SEQ - 1 ? SEQ - 1 : kp);
    const u16* kb = Pb + (size_t)kp * NP + 1408 + hd * 64 + h * 8;
#pragma unroll
    for (int s = 0; s < 4; s++) kf[s] = *(const bf16x8*)(kb + s * 16);
#pragma unroll
    for (int i = 0; i < 4; i++) {
      int c = lane + 64 * i;
      int row = c >> 3, ch = c & 7;
      int vp = lo + g * row;
      vp = vp < 0 ? 0 : (vp > SEQ - 1 ? SEQ - 1 : vp);
      rv[i] = *(const u32x4*)(Pb + (size_t)vp * NP + 1792 + hd * 64 + ch * 8);
    }
  };
  auto body = [&](int u, bf16x8 (&kf)[4], u32x4 (&rv)[4], u16* Vb) {
    int g, lo;
    unit_geom(u, g, lo);
#pragma unroll
    for (int i = 0; i < 4; i++) {
      int c = lane + 64 * i;
      *(u32x4*)(Vb + (c >> 3) * 72 + (c & 7) * 8) = rv[i];
    }
    f32x16 S;
#pragma unroll
    for (int i = 0; i < 16; i++) S[i] = negM;
#pragma unroll
    for (int s = 0; s < 4; s++) S = mfma32(kf[s], qf[s], S);
    if (u + 2 < 33) prefetch(u + 2, kf, rv);
    const int W = 64 * g;
    const int lob = qpos - W > 0 ? qpos - W : 0;
    const int hib = qpos + W < SEQ - 1 ? qpos + W : SEQ - 1;
    const unsigned rng = (unsigned)(hib - lob);
    const int base = lo + 4 * g * h - lob;
    float ps = 0.f;
#pragma unroll
    for (int i = 0; i < 16; i++) {
      const bool valid = (unsigned)(base + g * ((i & 3) + 8 * (i >> 2))) <= rng;
      float pv = valid ? fexp2(S[i]) : 0.f;
      ps += pv;
      S[i] = pv;
    }
    lsum += ps;
    bf16x8 pf0 = pack_p(S, 0), pf1 = pack_p(S, 1);
    asm volatile("s_waitcnt lgkmcnt(0)" ::: "memory");
#pragma unroll
    for (int dt = 0; dt < 2; dt++) {
      bf16x8 v0 = load_vfrag(Vb, 72, 0, dt * 32, lane);
      O[dt] = mfma32(v0, pf0, O[dt]);
      bf16x8 v1 = load_vfrag(Vb, 72, 16, dt * 32, lane);
      O[dt] = mfma32(v1, pf1, O[dt]);
    }
  };
  u16* Vw0 = (u16*)smem + wave * 2 * 32 * 72;
  u16* Vw1 = Vw0 + 32 * 72;
  prefetch(0, kf0, rv0);
  prefetch(1, kf1, rv1);
  for (int u = 0; u < 33; u += 2) {
    body(u, kf0, rv0, Vw0);
    if (u + 1 < 33) body(u + 1, kf1, rv1, Vw1);
  }
  const float lt = lsum + xhalf(lsum);
  const float inv = 1.f / lt;
  const size_t tok = (size_t)b * SEQ + qpos;
#pragma unroll
  for (int dt = 0; dt < 2; dt++)
#pragma unroll
    for (int gq = 0; gq < 4; gq++) {
      const int d0 = dt * 32 + 8 * gq + 4 * h;
      u32x2 gt = *(const u32x2*)(p.pbuf + tok * NP + 2176 + hd * 64 + d0);
      float v0 = O[dt][4 * gq + 0] * inv * bf_lo(gt[0]);
      float v1 = O[dt][4 * gq + 1] * inv * bf_hi(gt[0]);
      float v2 = O[dt][4 * gq + 2] * inv * bf_lo(gt[1]);
      float v3 = O[dt][4 * gq + 3] * inv * bf_hi(gt[1]);
      u32x2 o = {pk2(v0, v1), pk2(v2, v3)};
      *(u32x2*)(p.ybuf + toff(tok, 256 + hd * 64 + d0)) = o;
    }
}

__device__ void phase_mix(const Params& p, int l, char* smem, int bid, int nb) {
  unsigned* ev = p.bar + 0;
  const bool xs = (opq(nb) & 7) == 0;
  const int xcd = xs ? (bid & 7) : 0, jl = xs ? (bid >> 3) : bid, nj = xs ? (nb >> 3) : nb;
  const int nS = xs ? 64 : 512, nB = xs ? 96 : 768;
  const bool noshiftA = p.ctab[l * 16 + 12] <= 64.f;
  for (int li = jl; li < nS; li += nj) { retS_task(p, l, xcd * nS + li, smem); event_signal(ev); __syncthreads(); }
  unsigned* ev2 = p.bar + 64;
  {
    const int nscan = xs ? 8 : 64;
    const int first = nj - nscan;
    if (jl >= first && jl - first < nscan) {
      event_wait(ev, 512u * (unsigned)(l + 1));
      retScan_task(p, l, xcd * nscan + (jl - first));
      asm volatile("s_waitcnt vmcnt(0)" ::: "memory");
      __syncthreads();
      if (opaque_tid() == 0) {
        __builtin_amdgcn_fence(__ATOMIC_RELEASE, "agent");
        asm volatile("s_waitcnt vmcnt(0)" ::: "memory");
        (void)__hip_atomic_fetch_add(ev2, 1u, __ATOMIC_RELAXED, __HIP_MEMORY_SCOPE_AGENT);
      }
      __syncthreads();
    }
  }
  for (int li = jl; li < nS; li += nj) {
    for (int rep = 0; rep < opq(REP_A); rep++) {
      if (noshiftA) attnA_task<false>(p, l, xcd * nS + li, smem); else attnA_task<true>(p, l, xcd * nS + li, smem);
      __syncthreads();
    }
  }
  for (int li = jl; li < nB; li += nj) {
    for (int rep = 0; rep < opq(REP_B); rep++) { attnB_task(p, l, xcd * nB + li, smem); __syncthreads(); }
  }
  event_wait(ev2, 64u * (unsigned)(l + 1));
  for (int li = jl; li < nS; li += nj) {
    for (int rep = 0; rep < opq(REP_C); rep++) { retO_task(p, l, xcd * nS + li, smem); __syncthreads(); }
  }
}

#define XB_TMO      128
#define XB_XCNT(j)  (256  + 64 * (j))
#define XB_XSUB(j)  (1280 + 64 * (j))
#define XB_XGEN(j)  (2304 + 64 * (j))
#define XB_TOP      3328
#define XB_TOPGEN   3392
#define XCD_BAR_WORDS 3456
#define XB_SPIN_CAP (1u << 22)
#define LAS __attribute__((address_space(3)))
__device__ __forceinline__ unsigned xb_ld(unsigned* p) { return __hip_atomic_load(p, __ATOMIC_RELAXED, __HIP_MEMORY_SCOPE_AGENT); }
__device__ __forceinline__ unsigned xb_add(unsigned* p, unsigned v) { return __hip_atomic_fetch_add(p, v, __ATOMIC_RELAXED, __HIP_MEMORY_SCOPE_AGENT); }
__device__ __forceinline__ unsigned xb_xcc_id() { return (unsigned)__builtin_amdgcn_s_getreg((3 << 11) | 20) & 0xFu; }
#define XB_SPIN(cond, bar) do { unsigned _sp = 0; while (cond) { __builtin_amdgcn_s_sleep(1); \
    if ((++_sp & 255u) == 0u) { if (xb_ld(&(bar)[XB_TMO])) break; if (_sp > XB_SPIN_CAP) { atomicAdd(&(bar)[XB_TMO], 1u); break; } } } } while (0)
struct XcdBarrier { unsigned* bar; unsigned x; volatile LAS unsigned* st; };
__device__ __forceinline__ XcdBarrier xcd_barrier_post(unsigned* bar, volatile LAS unsigned* st) {
  XcdBarrier b; b.bar = bar; b.x = xb_xcc_id(); b.st = st;
  if (opaque_tid() == 0) (void)xb_add(&bar[XB_XCNT(b.x)], 1u);
  return b;
}
__device__ __forceinline__ void xcd_barrier_complete(unsigned* bar, unsigned x, unsigned& nloc, unsigned& nx) {
  const unsigned G = gridDim.x * gridDim.y * gridDim.z;
  unsigned sum, cnt, mine, sp = 0u;
  for (;;) {
    sum = 0u; cnt = 0u; mine = 0u;
#pragma unroll
    for (unsigned j = 0; j < 16; ++j) { const unsigned c = xb_ld(&bar[XB_XCNT(j)]); sum += c; cnt += (c > 0u) ? 1u : 0u; mine = (j == x) ? c : mine; }
    if (sum == G) break;
    __builtin_amdgcn_s_sleep(1);
    if ((++sp & 255u) == 0u) { if (xb_ld(&bar[XB_TMO])) break; if (sp > XB_SPIN_CAP) { atomicAdd(&bar[XB_TMO], 1u); break; } }
  }
  nloc = mine > 0u ? mine : 1u; nx = cnt > 0u ? cnt : 1u;
}
__device__ __forceinline__ void xcd_barrier(const XcdBarrier& b) {
  asm volatile("s_waitcnt vmcnt(0)" ::: "memory");
  __syncthreads();
  if (opaque_tid() == 0) {
    unsigned* bar = b.bar;
    __builtin_amdgcn_s_waitcnt(0);
    unsigned nloc = b.st[0], nx = b.st[1];
    if (nloc == 0u) { xcd_barrier_complete(bar, b.x, nloc, nx); b.st[0] = nloc; b.st[1] = nx; }
    const unsigned old = xb_add(&bar[XB_XSUB(b.x)], 1u);
    const unsigned gen = old / nloc;
    if (old + 1u == (gen + 1u) * nloc) {
      __builtin_amdgcn_fence(__ATOMIC_RELEASE, "agent");
      asm volatile("s_waitcnt vmcnt(0)" ::: "memory");
      const unsigned og = xb_add(&bar[XB_TOP], 1u);
      const unsigned tg = og / nx;
      if (og + 1u == (tg + 1u) * nx) xb_add(&bar[XB_TOPGEN], 1u);
      else XB_SPIN(xb_ld(&bar[XB_TOPGEN]) == tg, bar);
      __builtin_amdgcn_fence(__ATOMIC_ACQUIRE, "agent");
      xb_add(&bar[XB_XGEN(b.x)], 1u);
      asm volatile("s_waitcnt vmcnt(0)" ::: "memory");
    } else {
      XB_SPIN(xb_ld(&bar[XB_XGEN(b.x)]) == gen, bar);
      __builtin_amdgcn_fence(__ATOMIC_ACQUIRE, "agent");
      asm volatile("s_waitcnt vmcnt(0)" ::: "memory");
    }
  }
  __syncthreads();
}

#if USE_COOP
__global__ void __launch_bounds__(256, 2) mega(Params p, int ph_lo, int ph_hi, int coop) {
  __shared__ __attribute__((aligned(16))) char smem[SMEM_BYTES];
  __shared__ uint4 xb_words;
  const int bid = blockIdx.x, nb = gridDim.x;
  if (threadIdx.x == 0) xb_words = make_uint4(0u, 0u, 0u, 0u);
  __syncthreads();
  if (coop) (void)xcd_barrier_post(p.bar, (volatile LAS unsigned*)&xb_words);
  if (ph_hi > 1000) cg::this_grid().sync();
  for (int ph = ph_lo; ph < ph_hi; ph++) {
    if (ph == 0) { for (int rep = 0; rep < opq(REP_P0); rep++) phase0(p, smem, bid, nb); }
    else if (ph == 1) phase0b(p, bid, nb);
    else {
      const int l = (ph - 2) >> 2, sub = (ph - 2) & 3;
      const float* xin = l == 0 ? p.x : p.out;
      if (sub == 0) { for (int rep = 0; rep < opq(REP_N); rep++) phase_norm(p, l, xin, bid, nb); }
      else if (sub == 1) { for (int rep = 0; rep < opq(REP_G0); rep++) phase_gemm<0>(p, l, xin, p.out, smem, bid, nb); }
      else if (sub == 2) phase_mix(p, l, smem, bid, nb);
      else {
        for (int rep = 1; rep < opq(REP_G1); rep++) phase_gemm<1>(p, l, xin, (float*)p.pbuf, smem, bid, nb);
        phase_gemm<1>(p, l, xin, p.out, smem, bid, nb);
      }
    }
    if (coop && ph + 1 < ph_hi) {
      XcdBarrier xb;
      xb.bar = p.bar; xb.x = xb_xcc_id(); xb.st = (volatile LAS unsigned*)&xb_words;
      xcd_barrier(xb);
    }
  }
}
#else
__global__ void __launch_bounds__(256, 2) k_phase0(Params p) {
  __shared__ __attribute__((aligned(16))) char smem[SMEM_BYTES];
  phase0(p, smem, blockIdx.x, gridDim.x);
}
__global__ void __launch_bounds__(256, 2) k_phase0b(Params p) { phase0b(p, blockIdx.x, gridDim.x); }
__global__ void __launch_bounds__(256, 2) k_norm(Params p, int l) {
  phase_norm(p, l, l == 0 ? p.x : p.out, blockIdx.x, gridDim.x);
}
template <int MODE>
__global__ void __launch_bounds__(256, 2) k_gemm(Params p, int l) {
  __shared__ __attribute__((aligned(16))) char smem[SMEM_BYTES];
  phase_gemm<MODE>(p, l, l == 0 ? p.x : p.out, p.out, smem, blockIdx.x, gridDim.x);
}
template <int WHICH>
__global__ void __launch_bounds__(256, WHICH == 0 ? 1 : 2) k_mix(Params p, int l) {
  __shared__ __attribute__((aligned(16))) char smem[SMEM_BYTES];
  if (WHICH == 0) { for (int t = blockIdx.x; t < 512; t += gridDim.x) { attnA_task<true>(p, l, t, smem); __syncthreads(); } }
  if (WHICH == 1) { for (int t = blockIdx.x; t < 512; t += gridDim.x) { retS_task(p, l, t, smem); __syncthreads(); } }
  if (WHICH == 3) { for (int t = blockIdx.x; t < 512; t += gridDim.x) { retO_task(p, l, t, smem); __syncthreads(); } }
  if (WHICH == 2) { for (int t = blockIdx.x; t < 768; t += gridDim.x) { attnB_task(p, l, t, smem); __syncthreads(); } }
}
#endif

extern "C" void kernel_launch(void* const* d_in, const int* in_sizes, int n_in, void* d_out, int out_size,
                              void* d_ws, size_t ws_size, hipStream_t stream) {
  Params p{};
  p.x = (const float*)d_in[0]; p.c = (const float*)d_in[1]; p.norm_g = (const float*)d_in[2];
  p.w_ada = (const float*)d_in[3]; p.b_ada = (const float*)d_in[4]; p.w_in = (const float*)d_in[5];
  p.w_out = (const float*)d_in[6]; p.qn_a = (const float*)d_in[7]; p.kn_a = (const float*)d_in[8];
  p.lq1 = (const float*)d_in[9]; p.lk1 = (const float*)d_in[10]; p.lq2 = (const float*)d_in[11];
  p.lk2 = (const float*)d_in[12]; p.subln_a = (const float*)d_in[13]; p.qn_b = (const float*)d_in[14];
  p.kn_b = (const float*)d_in[15]; p.ret_decay = (const float*)d_in[16]; p.gn_c = (const float*)d_in[17];
  p.out = (float*)d_out;
  char* ws = (char*)d_ws;
  size_t off = 0;
  auto take = [&](size_t bytes) { char* q = ws + off; off += (bytes + 255) & ~(size_t)255; return q; };
  p.wt_in = (u16*)take((size_t)4 * NP * 1024 * 2);
  p.wt_out = (u16*)take((size_t)4 * 1024 * 1024 * 2);
  p.hbuf = (u16*)take((size_t)NTOK * 1024 * 2);
  p.pbuf = (u16*)take((size_t)NTOK * NP * 2);
  p.ybuf = (u16*)take((size_t)NTOK * 1024 * 2);
  p.modp = (float*)take((size_t)16 * 49152 * 4);
  p.mod = (float*)take((size_t)49152 * 4);
  p.rope = (float*)take((size_t)4096 * 72 * 4);
  p.bar = (unsigned*)take((size_t)XCD_BAR_WORDS * 4);
  p.ctab = (float*)take(64 * 4);
  p.state = (float*)p.hbuf;

#if USE_COOP
  static int grid_blocks = 0;
  if (!grid_blocks) {
    int dev = 0, cus = 0, per_cu = 0;
    (void)hipGetDevice(&dev);
    (void)hipDeviceGetAttribute(&cus, hipDeviceAttributeMultiprocessorCount, dev);
    (void)hipOccupancyMaxActiveBlocksPerMultiprocessor(&per_cu, mega, 256, 0);
    if (per_cu < 1) per_cu = 1;
    if (per_cu > 2) per_cu = 2;
    grid_blocks = cus * per_cu;
  }
  (void)hipMemsetAsync(p.bar, 0, (size_t)XCD_BAR_WORDS * 4, stream);
  int lo = 0, hi = 18, coop = 1;
  void* args[] = {&p, &lo, &hi, &coop};
  hipError_t e = hipLaunchCooperativeKernel((void*)mega, dim3(grid_blocks), dim3(256), args, 0, stream);
  if (e != hipSuccess) fprintf(stderr, "cooperative launch failed: %s (grid %d)\n", hipGetErrorString(e), grid_blocks);
#else
  const int G = 512;
  k_phase0<<<G, 256, 0, stream>>>(p);
  k_phase0b<<<G, 256, 0, stream>>>(p);
  for (int l = 0; l < 4; l++) {
    k_norm<<<G, 256, 0, stream>>>(p, l);
    k_gemm<0><<<G, 256, 0, stream>>>(p, l);
    k_mix<0><<<G, 256, 0, stream>>>(p, l);
    k_mix<1><<<G, 256, 0, stream>>>(p, l);
    k_mix<3><<<G, 256, 0, stream>>>(p, l);
    k_mix<2><<<G, 256, 0, stream>>>(p, l);
    k_gemm<1><<<G, 256, 0, stream>>>(p, l);
  }
#endif
}
```

```cpp
#include <hip/hip_runtime.h>
#include <hip/hip_cooperative_groups.h>
#include <stdint.h>
#include <stdio.h>
namespace cg = cooperative_groups;

#ifndef REP_G0
#define REP_G0 1
#endif
#ifndef REP_G1
#define REP_G1 1
#endif
#ifndef REP_A
#define REP_A 1
#endif
#ifndef REP_B
#define REP_B 1
#endif
#ifndef REP_C
#define REP_C 1
#endif
#ifndef REP_N
#define REP_N 1
#endif
#ifndef REP_P0
#define REP_P0 1
#endif
#ifndef USE_COOP
#define USE_COOP 1
#endif

typedef unsigned short u16;
typedef short bf16x8 __attribute__((ext_vector_type(8)));
typedef short s16x4 __attribute__((ext_vector_type(4)));
typedef float f32x16 __attribute__((ext_vector_type(16)));
typedef float f32x4 __attribute__((ext_vector_type(4)));
typedef float f32x2 __attribute__((ext_vector_type(2)));
typedef unsigned int u32x4 __attribute__((ext_vector_type(4)));
typedef unsigned int u32x2 __attribute__((ext_vector_type(2)));
typedef __bf16 bf16v2 __attribute__((ext_vector_type(2)));

constexpr int NP = 3840;
constexpr int SEQ = 4096;
constexpr int NTOK = 16384;
constexpr float LOG2E = 1.4426950408889634f;
constexpr int SMEM_BYTES = 73728;

struct Params {
  const float *x, *c, *norm_g, *w_ada, *b_ada, *w_in, *w_out, *qn_a, *kn_a, *lq1, *lk1, *lq2, *lk2,
      *subln_a, *qn_b, *kn_b, *ret_decay, *gn_c;
  float* out;
  u16 *wt_in, *wt_out, *hbuf, *pbuf, *ybuf;
  float *modp, *mod, *rope, *state, *ctab;
  unsigned* bar;
};


template <typename T>
__device__ __forceinline__ void launder(T*& ptr) {
  auto g = (__attribute__((address_space(1))) T*)ptr;
  asm volatile("" : "+s"(g));
  ptr = (T*)g;
}
__device__ __forceinline__ Params opaque_params(const Params& p) {
  Params q = p;
  launder(q.x); launder(q.c); launder(q.norm_g); launder(q.w_ada); launder(q.b_ada); launder(q.w_in); launder(q.w_out);
  launder(q.qn_a); launder(q.kn_a); launder(q.lq1); launder(q.lk1); launder(q.lq2); launder(q.lk2); launder(q.subln_a);
  launder(q.qn_b); launder(q.kn_b); launder(q.ret_decay); launder(q.gn_c); launder(q.out);
  launder(q.wt_in); launder(q.wt_out); launder(q.hbuf); launder(q.pbuf); launder(q.ybuf);
  launder(q.modp); launder(q.mod); launder(q.rope); launder(q.state); launder(q.ctab); launder(q.bar);
  return q;
}

typedef __attribute__((address_space(1))) unsigned long long gu64;
typedef __attribute__((address_space(1))) unsigned int gu32;
__device__ __forceinline__ void store_wt_f32(float* ptr, float v) {
  __hip_atomic_store((gu32*)ptr, __float_as_uint(v), __ATOMIC_RELAXED, __HIP_MEMORY_SCOPE_AGENT);
}

__device__ __forceinline__ size_t toff(size_t row, int k) {
  return ((row >> 1) * 32 + (size_t)(k >> 5)) * 64 + (row & 1) * 32 + (k & 31);
}
__device__ __forceinline__ uint32_t pk2(float a, float b) {
  f32x2 v = {a, b};
  bf16v2 r = __builtin_convertvector(v, bf16v2);
  return __builtin_bit_cast(uint32_t, r);
}
__device__ __forceinline__ float bf_lo(uint32_t u) { return __uint_as_float(u << 16); }
__device__ __forceinline__ float bf_hi(uint32_t u) { return __uint_as_float(u & 0xffff0000u); }
__device__ __forceinline__ float fexp2(float x) { return __builtin_amdgcn_exp2f(x); }
__device__ __forceinline__ float xhalf(float v) { return __shfl_xor(v, 32); }
__device__ __forceinline__ float silu_f(float v) { return v * __builtin_amdgcn_rcpf(1.f + __expf(-v)); }

#define LDSP __attribute__((address_space(3)))
#define RAW_BARRIER() do { asm volatile("s_waitcnt lgkmcnt(0)" ::: "memory"); __builtin_amdgcn_s_barrier(); } while (0)
__device__ __forceinline__ int opaque_tid() {
  int t = threadIdx.x;
  asm volatile("" : "+v"(t));
  return t;
}
__device__ __forceinline__ int opq(int v) {
  asm volatile("" : "+s"(v));
  return v;
}
__device__ __forceinline__ f32x16 mfma32(bf16x8 a, bf16x8 b, f32x16 c) {
  return __builtin_amdgcn_mfma_f32_32x32x16_bf16(a, b, c, 0, 0, 0);
}

__device__ __forceinline__ bf16x8 load_vfrag(const u16* Vs, int pitch, int key0, int d0, int lane) {
  int G = lane >> 4, i = lane & 15;
  int row = key0 + 4 * (G >> 1) + (i >> 2);
  int col = d0 + 16 * (G & 1) + 4 * (i & 3);
  const u16* a0 = Vs + row * pitch + col;
  const u16* a1 = a0 + 8 * pitch;
  s16x4 lo = __builtin_amdgcn_ds_read_tr16_b64_v4i16((__attribute__((address_space(3))) s16x4*)a0);
  s16x4 hi = __builtin_amdgcn_ds_read_tr16_b64_v4i16((__attribute__((address_space(3))) s16x4*)a1);
  bf16x8 r;
  r[0] = lo[0]; r[1] = lo[1]; r[2] = lo[2]; r[3] = lo[3];
  r[4] = hi[0]; r[5] = hi[1]; r[6] = hi[2]; r[7] = hi[3];
  return r;
}

__device__ __forceinline__ bf16x8 pack_p(const f32x16& s, int s2) {
  u32x4 w;
  w[0] = pk2(s[8 * s2 + 0], s[8 * s2 + 1]);
  w[1] = pk2(s[8 * s2 + 2], s[8 * s2 + 3]);
  w[2] = pk2(s[8 * s2 + 4], s[8 * s2 + 5]);
  w[3] = pk2(s[8 * s2 + 6], s[8 * s2 + 7]);
  return __builtin_bit_cast(bf16x8, w);
}

__device__ void phase0(const Params& p_in, char* smem, int bid, int nb) {
  const Params p = opaque_params(p_in);
  const int tid = opaque_tid();
  const int NT_IN = 4 * 16 * 30, NT_OUT = 4 * 16 * 8, NT_ADA = 768, NT_ROPE = 576;
  for (int t = bid; t < NT_IN + NT_OUT + NT_ADA + NT_ROPE; t += nb) {
    if (t < NT_IN + NT_OUT) {
      float* tile = (float*)smem;
      const bool isin = t < NT_IN;
      const int tt = isin ? t : t - NT_IN;
      const int ntn = isin ? 30 : 8;
      const int l = tt / (16 * ntn);
      const int rem = tt % (16 * ntn);
      const int kt = rem / ntn, nt = rem % ntn;
      const int ncols = isin ? 3712 : 1024;
      const float* src = isin ? p.w_in + (size_t)l * 1024 * 3712 : p.w_out + (size_t)l * 1024 * 1024;
      const int np = nt * 128 + (tid & 127);
      int col = np;
      if (isin) {
        if (np >= 3072) col = np - 128;
        else if (np >= 2560) {
          int q = np - 2560;
          int region = q >> 8, hh = (q & 255) >> 6, d = q & 63;
          col = d < 48 ? 2560 + region * 192 + hh * 48 + d : -1;
        }
      }
      const float* sp = src + (size_t)(kt * 64 + (tid >> 7)) * ncols + (col >= 0 ? col : 0);
      float vals[32];
#pragma unroll
      for (int i = 0; i < 32; i++) vals[i] = __builtin_nontemporal_load(sp + (size_t)(2 * i) * ncols);
#pragma unroll
      for (int i = 0; i < 32; i++) tile[(2 * i + (tid >> 7)) * 129 + (tid & 127)] = col >= 0 ? vals[i] : 0.f;
      __syncthreads();
      {
        const int n = tid >> 1, ks = (tid & 1) * 32;
        u16* wbase = isin ? p.wt_in + (size_t)l * NP * 1024 : p.wt_out + (size_t)l * 1024 * 1024;
        const size_t wrow = (size_t)nt * 128 + n;
#pragma unroll
        for (int q4 = 0; q4 < 4; q4++) {
          uint32_t w[4];
#pragma unroll
          for (int j = 0; j < 4; j++)
            w[j] = pk2(tile[(ks + 8 * q4 + 2 * j) * 129 + n], tile[(ks + 8 * q4 + 2 * j + 1) * 129 + n]);
          u32x4 wv = {w[0], w[1], w[2], w[3]};
          *(u32x4*)(wbase + toff(wrow, kt * 64 + ks + 8 * q4)) = wv;
        }
      }
      __syncthreads();
    } else if (t < NT_IN + NT_OUT + NT_ADA) {
      const int tt = t - (NT_IN + NT_OUT);
      const int l = tt / 192;
      const int rem = tt % 192;
      const int cb = rem / 16, kc = rem % 16;
      float* cs = (float*)smem;
      {
        int b = tid >> 6, kk = tid & 63;
        float cv = p.c[b * 1024 + kc * 64 + kk];
        cs[tid] = cv / (1.f + expf(-cv));
      }
      __syncthreads();
      const int col = cb * 256 + tid;
      float a0 = 0.f, a1 = 0.f, a2 = 0.f, a3 = 0.f;
      const float* w = p.w_ada + ((size_t)l * 1024 + kc * 64) * 3072 + col;
#pragma unroll 8
      for (int kk = 0; kk < 64; kk++) {
        float wv = __builtin_nontemporal_load(w + (size_t)kk * 3072);
        a0 += cs[kk] * wv;
        a1 += cs[64 + kk] * wv;
        a2 += cs[128 + kk] * wv;
        a3 += cs[192 + kk] * wv;
      }
      if (kc == 0) {
        float bv = p.b_ada[l * 3072 + col];
        a0 += bv; a1 += bv; a2 += bv; a3 += bv;
      }
      float* mp = p.modp + ((size_t)(kc * 4 + l) * 4) * 3072 + col;
      mp[0] = a0; mp[3072] = a1; mp[2 * 3072] = a2; mp[3 * 3072] = a3;
      __syncthreads();
    } else {
      const int tt = t - (NT_IN + NT_OUT + NT_ADA);
      const int e = tt * 256 + tid;
      if (tt == 0 && tid < 4) {
        const int l = tid;
        float d1 = 0.f, d2 = 0.f, ka = 0.f, kb = 0.f;
        for (int j = 0; j < 32; j++) {
          d1 += p.lq1[l * 32 + j] * p.lk1[l * 32 + j];
          d2 += p.lq2[l * 32 + j] * p.lk2[l * 32 + j];
          ka = fmaxf(ka, fabsf(p.kn_a[l * 32 + j]));
        }
        for (int j = 0; j < 64; j++) kb = fmaxf(kb, fabsf(p.kn_b[l * 64 + j]));
        const float lam_init = 0.8f - 0.6f * expf(-0.3f * (float)l);
        float* ct = p.ctab + l * 16;
        ct[0] = expf(d1) - expf(d2) + lam_init;
        ct[1] = 1.f - lam_init;
        for (int hd = 0; hd < 4; hd++) {
          const float xf = p.ret_decay[(l * 2 + 0) * 4 + hd], xb = p.ret_decay[(l * 2 + 1) * 4 + hd];
          ct[2 + hd] = -log1pf(expf(-xf)) * LOG2E;
          ct[6 + hd] = -log1pf(expf(-xb)) * LOG2E;
        }
        float qa = 0.f;
        for (int j = 0; j < 32; j++) qa = fmaxf(qa, fabsf(p.qn_a[l * 32 + j]));
        ct[10] = ka * 5.656854249492381f * 1.01f;
        ct[12] = qa * 5.656854249492381f * 0.17677669529663687f * LOG2E * 1.01f * ct[10];
        ct[11] = kb * 8.f * 1.01f;
      }
      if (e < 4096 * 36) {
        int pos = e / 36, j = e % 36;
        float expo;
        if (j < 4) expo = -(float)j * (18.931568569324174f / 4.f);
        else if (j < 12) expo = -(float)(j - 4) * (18.931568569324174f / 8.f);
        else expo = -(float)(j - 12) * (13.287712379549449f / 24.f);
        float inv = exp2f(expo);
        float ang = (float)pos * inv;
        double rev = (double)ang * 0.15915494309189535;
        rev -= rint(rev);
        float rf = (float)(rev * 6.283185307179586);
        p.rope[2 * e] = __cosf(rf);
        p.rope[2 * e + 1] = __sinf(rf);
      }
    }
  }
}

__device__ void phase0b(const Params& p_in, int bid, int nb) {
  const Params p = opaque_params(p_in);
  for (int idx = bid * 256 + opaque_tid(); idx < 49152; idx += nb * 256) {
    float s = 0.f;
#pragma unroll
    for (int kc = 0; kc < 16; kc++) s += p.modp[(size_t)kc * 49152 + idx];
    p.mod[idx] = s;
  }
}

__device__ void phase_norm(const Params& p_in, int l, const float* xin, int bid, int nb) {
  const Params p = opaque_params(p_in);
  const int tid = opaque_tid(), wave = tid >> 6, lane = tid & 63;
  for (int grp = bid * 4 + wave; grp < NTOK / 8; grp += nb * 4) {
    const int row0 = grp * 8;
    const int b = row0 >> 12;
    const float* mo = p.mod + (size_t)(l * 4 + b) * 3072;
    const float* g = p.norm_g + l * 1024;
    f32x4 gm[4], sh[4];
#pragma unroll
    for (int i = 0; i < 4; i++) {
      const int col = i * 256 + lane * 4;
      f32x4 gv = *(const f32x4*)(g + col);
      f32x4 sc = *(const f32x4*)(mo + 1024 + col);
      sh[i] = *(const f32x4*)(mo + col);
      gm[i] = gv * (1.f + sc);
    }
#pragma unroll 2
    for (int k = 0; k < 8; k++) {
      const int row = row0 + k;
      const float* xr = xin + (size_t)row * 1024;
      f32x4 v[4];
      float ss = 0.f;
#pragma unroll
      for (int i = 0; i < 4; i++) {
        v[i] = __builtin_nontemporal_load((const f32x4*)(xr + i * 256 + lane * 4));
        ss += v[i][0] * v[i][0] + v[i][1] * v[i][1] + v[i][2] * v[i][2] + v[i][3] * v[i][3];
      }
#pragma unroll
      for (int o = 32; o >= 1; o >>= 1) ss += __shfl_xor(ss, o);
      const float rstd = rsqrtf(ss * (1.f / 1024.f) + 1e-6f);
#pragma unroll
      for (int i = 0; i < 4; i++) {
        const int col = i * 256 + lane * 4;
        f32x4 y = v[i] * rstd * gm[i] + sh[i];
        u32x2 o = {pk2(y[0], y[1]), pk2(y[2], y[3])};
        *(u32x2*)(p.hbuf + toff((size_t)row, col)) = o;
      }
    }
  }
}

template <int MODE>
__device__ void phase_gemm(const Params& p_in, int l, const float* xin, float* outp, char* smem, int bid, int nb) {
  const Params p = opaque_params(p_in);
  const int tid = opaque_tid(), wave = tid >> 6, lane = tid & 63, r = lane & 31, h = lane >> 5;
  const int wm = wave >> 1, wn = wave & 1;
  const u16* A = MODE == 0 ? p.hbuf : p.ybuf;
  const u16* Bt = MODE == 0 ? p.wt_in + (size_t)l * NP * 1024 : p.wt_out + (size_t)l * 1024 * 1024;
  constexpr int NTN = MODE == 0 ? 30 : 8;
  constexpr int ntiles = 64 * NTN;
  const bool xs = (opq(nb) & 7) == 0;
  const int xcd = xs ? (bid & 7) : 0, jl = xs ? (bid >> 3) : bid, nj = xs ? (nb >> 3) : nb;
  const int per_x = xs ? ntiles / 8 : ntiles;
  for (int li = jl; li < per_x; li += nj) {
    int mt, nt;
    if (xs) {
      if (MODE == 0) {
        const int rect = li / 60, within = li % 60;
        mt = 8 * xcd + 4 * (rect >> 1) + (within & 3);
        nt = 15 * ((rect & 1) ^ ((rect >> 1) & 1)) + (within >> 2);
      } else {
        mt = 8 * xcd + (li >> 3);
        nt = li & 7;
      }
    } else {
      mt = li / NTN; nt = li % NTN;
    }
    const int m0 = mt * 256, n0 = nt * 128;
    f32x16 acc[4][2];
#pragma unroll
    for (int a = 0; a < 4; a++)
#pragma unroll
      for (int b2 = 0; b2 < 2; b2++)
#pragma unroll
        for (int i = 0; i < 16; i++) acc[a][b2][i] = 0.f;
    {
      const int i_row = lane >> 2;
      const int cl = (lane & 3) ^ ((i_row >> 2) & 3);
      const u16* gA0 = A + toff((size_t)(m0 + 64 * wave + i_row), cl * 8);
      const u16* gB0 = Bt + toff((size_t)(n0 + 32 * wave + i_row), cl * 8);
      const int physx = (r >> 2) & 3;
      const uint32_t lds_base = (uint32_t)(size_t)(LDSP char*)smem;
      auto issue1 = [&](int kt, int buf, int idx) {
        char* st = smem + buf * 24576;
        if (idx < 4) {
          __builtin_amdgcn_global_load_lds((const unsigned*)(gA0 + kt * 64 + idx * 16384),
                                           (LDSP unsigned*)(st + wave * 4096 + idx * 1024), 16, 0, 0);
        } else {
          __builtin_amdgcn_global_load_lds((const unsigned*)(gB0 + kt * 64 + (idx - 4) * 16384),
                                           (LDSP unsigned*)(st + 16384 + wave * 2048 + (idx - 4) * 1024), 16, 0, 0);
        }
      };
      auto issue = [&](int kt, int buf) {
#pragma unroll
        for (int idx = 0; idx < 6; idx++) issue1(kt, buf, idx);
      };
      asm volatile("s_waitcnt vmcnt(0)" ::: "memory");
      issue(0, 0); issue(1, 1);
      int buf = 0;
      for (int kt = 0; kt < 32; kt++) {
        if (kt < 31) asm volatile("s_waitcnt vmcnt(6)" ::: "memory");
        else asm volatile("s_waitcnt vmcnt(0)" ::: "memory");
        RAW_BARRIER();
        int nb2 = buf + 2; if (nb2 >= 3) nb2 -= 3;
        const bool pf = kt + 2 < 32;
        const uint32_t sta = lds_base + (uint32_t)(buf * 24576);
#pragma unroll
        for (int s2 = 0; s2 < 2; s2++) {
          const uint32_t phys = (uint32_t)(((2 * s2 + h) ^ physx) * 16);
          const uint32_t aaddr = sta + (uint32_t)((wm * 128 + r) * 64) + phys;
          const uint32_t baddr = sta + 16384u + (uint32_t)((wn * 64 + r) * 64) + phys;
          bf16x8 a0, a1, a2, a3, b0, b1;
          asm volatile("ds_read_b128 %0, %1" : "=v"(a0) : "v"(aaddr));
          asm volatile("ds_read_b128 %0, %1" : "=v"(b0) : "v"(baddr));
          asm volatile("ds_read_b128 %0, %1 offset:2048" : "=v"(b1) : "v"(baddr));
          asm volatile("ds_read_b128 %0, %1 offset:2048" : "=v"(a1) : "v"(aaddr));
          asm volatile("ds_read_b128 %0, %1 offset:4096" : "=v"(a2) : "v"(aaddr));
          asm volatile("ds_read_b128 %0, %1 offset:6144" : "=v"(a3) : "v"(aaddr));
          asm volatile("s_waitcnt lgkmcnt(3)" : "+v"(a0), "+v"(b0), "+v"(b1));
          __builtin_amdgcn_s_setprio(1);
          acc[0][0] = mfma32(a0, b0, acc[0][0]);
          acc[0][1] = mfma32(a0, b1, acc[0][1]);
          __builtin_amdgcn_sched_barrier(0);
          if (pf) issue1(kt + 2, nb2, 3 * s2 + 0);
          asm volatile("s_waitcnt lgkmcnt(2)" : "+v"(a1));
          acc[1][0] = mfma32(a1, b0, acc[1][0]);
          acc[1][1] = mfma32(a1, b1, acc[1][1]);
          __builtin_amdgcn_sched_barrier(0);
          if (pf) issue1(kt + 2, nb2, 3 * s2 + 1);
          asm volatile("s_waitcnt lgkmcnt(1)" : "+v"(a2));
          acc[2][0] = mfma32(a2, b0, acc[2][0]);
          acc[2][1] = mfma32(a2, b1, acc[2][1]);
          __builtin_amdgcn_sched_barrier(0);
          if (pf) issue1(kt + 2, nb2, 3 * s2 + 2);
          asm volatile("s_waitcnt lgkmcnt(0)" : "+v"(a3));
          acc[3][0] = mfma32(a3, b0, acc[3][0]);
          acc[3][1] = mfma32(a3, b1, acc[3][1]);
          __builtin_amdgcn_s_setprio(0);
          __builtin_amdgcn_sched_barrier(0);
        }
        buf = buf + 1; if (buf >= 3) buf = 0;
      }
      __syncthreads();
    }
    if (MODE == 1) {
#pragma unroll
      for (int mi = 0; mi < 4; mi++)
#pragma unroll
        for (int ni = 0; ni < 2; ni++) {
          const int col = n0 + wn * 64 + ni * 32 + r;
          const float g = p.mod[(size_t)(l * 4 + (m0 >> 12)) * 3072 + 2048 + col];
          const size_t rbase = (size_t)(m0 + wm * 128 + mi * 32 + 4 * h) * 1024 + col;
          float xo[16];
#pragma unroll
          for (int i = 0; i < 16; i++) xo[i] = xin[rbase + (size_t)((i & 3) + 8 * (i >> 2)) * 1024];
#pragma unroll
          for (int i = 0; i < 16; i++) outp[rbase + (size_t)((i & 3) + 8 * (i >> 2)) * 1024] = xo[i] + g * acc[mi][ni][i];
        }
    } else {
      float* Cw = (float*)smem + wave * (32 * 65);
      const int row = lane & 31, hf = lane >> 5;
#pragma unroll
      for (int mi = 0; mi < 4; mi++) {
#pragma unroll
        for (int ni = 0; ni < 2; ni++)
#pragma unroll
          for (int i = 0; i < 16; i++)
            Cw[((i & 3) + 8 * (i >> 2) + 4 * h) * 65 + ni * 32 + r] = acc[mi][ni][i];
        asm volatile("s_waitcnt lgkmcnt(0)" ::: "memory");
        float v[32];
#pragma unroll
        for (int j = 0; j < 32; j++) v[j] = Cw[row * 65 + hf * 32 + j];
        asm volatile("s_waitcnt lgkmcnt(0)" ::: "memory");
        const int tok = m0 + wm * 128 + mi * 32 + row;
        const int pos = tok & 4095;
        const float* rp = p.rope + (size_t)pos * 72;
        if (n0 < 512) {
          const bool isq = n0 < 256;
          const float* w = (isq ? p.qn_a : p.kn_a) + l * 32;
          const float qs = isq ? 0.17677669529663687f * LOG2E : 1.f;
          float ss = 0.f;
#pragma unroll
          for (int j = 0; j < 32; j++) ss += v[j] * v[j];
          const float rstd = rsqrtf(ss * (1.f / 32.f) + 1e-6f) * qs;
#pragma unroll
          for (int j = 0; j < 32; j++) v[j] = v[j] * rstd * w[j];
#pragma unroll
          for (int j = 0; j < 4; j++) {
            const float cs = rp[2 * j], sn = rp[2 * j + 1];
            const float x1 = v[j], x2 = v[4 + j];
            v[j] = x1 * cs - x2 * sn;
            v[4 + j] = x1 * sn + x2 * cs;
          }
        } else if (n0 >= 1024 && n0 < 1792) {
          const bool isq = n0 < 1408;
          const float* w = (isq ? p.qn_b : p.kn_b) + l * 64 + hf * 32;
          const float qs = isq ? 0.125f * LOG2E : 1.f;
          float ss = 0.f;
#pragma unroll
          for (int j = 0; j < 32; j++) ss += v[j] * v[j];
          ss += xhalf(ss);
          const float rstd = rsqrtf(ss * (1.f / 64.f) + 1e-6f) * qs;
#pragma unroll
          for (int j = 0; j < 32; j++) v[j] = v[j] * rstd * w[j];
          if (hf == 0) {
#pragma unroll
            for (int j = 0; j < 8; j++) {
              const float cs = rp[2 * (4 + j)], sn = rp[2 * (4 + j) + 1];
              const float x1 = v[j], x2 = v[8 + j];
              v[j] = x1 * cs - x2 * sn;
              v[8 + j] = x1 * sn + x2 * cs;
            }
          }
        } else if (n0 >= 2560 && n0 < 3072) {
          const float ksc = n0 >= 2816 ? 0.14433756729740643f : 1.f;
          float xv[16];
#pragma unroll
          for (int k = 0; k < 16; k++) {
            const uint32_t msk = 0u - (uint32_t)hf;
            const uint32_t snd = (__float_as_uint(v[k]) & msk) | (__float_as_uint(v[8 + k]) & ~msk);
            xv[k] = xhalf(__uint_as_float(snd));
          }
          if (hf == 0) {
#pragma unroll
            for (int j = 0; j < 8; j++) {
              const float cs = rp[2 * (12 + j)], sn = rp[2 * (12 + j) + 1];
              const float x1 = v[j], x2 = v[24 + j];
              v[j] = (x1 * cs - x2 * sn) * ksc;
              v[24 + j] = (x1 * sn + x2 * cs) * ksc;
            }
#pragma unroll
            for (int j = 8; j < 24; j++) {
              const float cs = rp[2 * (12 + j)], sn = rp[2 * (12 + j) + 1];
              v[j] = (v[j] * cs - xv[j - 8] * sn) * ksc;
            }
          } else {
#pragma unroll
            for (int k = 0; k < 16; k++) {
              const float cs = rp[2 * (12 + k + 8)], sn = rp[2 * (12 + k + 8) + 1];
              v[k] = (xv[k] * sn + v[k] * cs) * ksc;
            }
          }
        } else if ((n0 >= 768 && n0 < 1024) || (n0 >= 2176 && n0 < 2560) || n0 >= 3456) {
#pragma unroll
          for (int j = 0; j < 32; j++) v[j] = silu_f(v[j]);
        }
        {
          char* Cb = (char*)Cw;
#pragma unroll
          for (int j = 0; j < 4; j++) {
            u32x4 w4 = {pk2(v[8 * j], v[8 * j + 1]), pk2(v[8 * j + 2], v[8 * j + 3]), pk2(v[8 * j + 4], v[8 * j + 5]),
                        pk2(v[8 * j + 6], v[8 * j + 7])};
            *(u32x4*)(Cb + row * 144 + hf * 64 + j * 16) = w4;
          }
          asm volatile("s_waitcnt lgkmcnt(0)" ::: "memory");
          const int rr = lane >> 3, ch = lane & 7;
          u16* dstb = p.pbuf + (size_t)(m0 + wm * 128 + mi * 32 + rr) * NP + n0 + wn * 64 + ch * 8;
#pragma unroll
          for (int ps = 0; ps < 4; ps++) {
            u32x4 w4 = *(const u32x4*)(Cb + (rr + 8 * ps) * 144 + ch * 16);
            *(u32x4*)(dstb + (size_t)(8 * ps) * NP) = w4;
          }
          asm volatile("s_waitcnt lgkmcnt(0)" ::: "memory");
        }
      }
      __syncthreads();
    }
  }
}

template <bool B> struct BoolC { static constexpr bool v = B; };

template <bool SHIFT>
__device__ void attnA_task(const Params& p_in, int l, int task, char* smem) {
  const Params p = opaque_params(p_in);
  const int tid = opaque_tid(), wave = tid >> 6, lane = tid & 63, r = lane & 31, h = lane >> 5;
  const int b = task >> 7, hd = (task >> 5) & 3, qblk = task & 31;
  u16* Ks = (u16*)smem;
  u16* Vs = Ks + 64 * 72;
  const u16* Pb = p.pbuf + (size_t)b * SEQ * NP;
  const int qpos = qblk * 128 + wave * 32 + r;
  bf16x8 qf[2][2];
#pragma unroll
  for (int mp = 0; mp < 2; mp++)
#pragma unroll
    for (int s = 0; s < 2; s++)
      qf[mp][s] = *(const bf16x8*)(Pb + (size_t)qpos * NP + hd * 64 + mp * 32 + s * 16 + h * 8);
  f32x16 O[2][2];
#pragma unroll
  for (int a = 0; a < 2; a++)
#pragma unroll
    for (int c = 0; c < 2; c++)
#pragma unroll
      for (int i = 0; i < 16; i++) O[a][c][i] = 0.f;
  float lsum[2] = {0.f, 0.f};
  float negM[2];
  {
    const float kmax = p.ctab[l * 16 + 10];
#pragma unroll
    for (int mp = 0; mp < 2; mp++) {
      float q2 = 0.f;
#pragma unroll
      for (int s = 0; s < 2; s++)
#pragma unroll
        for (int j = 0; j < 8; j++) {
          float qv = __uint_as_float(((uint32_t)(unsigned short)qf[mp][s][j]) << 16);
          q2 += qv * qv;
        }
      q2 += xhalf(q2);
      negM[mp] = -sqrtf(q2) * kmax;
    }
  }
  bf16x8* Qw = (bf16x8*)(smem + 4 * 64 * 72 * 2) + wave * 256 + lane;
#pragma unroll
  for (int mp = 0; mp < 2; mp++)
#pragma unroll
    for (int s = 0; s < 2; s++) Qw[(mp * 2 + s) * 64] = qf[mp][s];
  const int lrow = tid >> 3, lch = tid & 7;
  u32x4 rk[2], rv[2];
  const u16* gbase = Pb + (size_t)lrow * NP + hd * 64 + lch * 8;
#pragma unroll
  for (int i = 0; i < 2; i++) {
    rk[i] = *(const u32x4*)(gbase + (size_t)(32 * i) * NP + 256);
    rv[i] = *(const u32x4*)(gbase + (size_t)(32 * i) * NP + 512);
  }
#pragma unroll
  for (int i = 0; i < 2; i++) {
    *(u32x4*)(Ks + (lrow + 32 * i) * 72 + lch * 8) = rk[i];
    *(u32x4*)(Vs + (lrow + 32 * i) * 72 + lch * 8) = rv[i];
  }
#pragma unroll
  for (int i = 0; i < 2; i++) {
    rk[i] = *(const u32x4*)(gbase + (size_t)(64 + 32 * i) * NP + 256);
    rv[i] = *(const u32x4*)(gbase + (size_t)(64 + 32 * i) * NP + 512);
  }
  __syncthreads();
  {
  for (int kt = 0; kt < 64; kt++) {
    const u16* Kc = Ks + (kt & 1) * (2 * 64 * 72);
    const u16* Vc = Kc + 64 * 72;
    if (kt + 1 < 64) {
      u16* Kn = Ks + ((kt + 1) & 1) * (2 * 64 * 72);
      u16* Vn = Kn + 64 * 72;
#pragma unroll
      for (int i = 0; i < 2; i++) {
        *(u32x4*)(Kn + (lrow + 32 * i) * 72 + lch * 8) = rk[i];
        *(u32x4*)(Vn + (lrow + 32 * i) * 72 + lch * 8) = rv[i];
      }
    }
    if (kt + 2 < 64) {
#pragma unroll
      for (int i = 0; i < 2; i++) {
        rk[i] = *(const u32x4*)(gbase + (size_t)((kt + 2) * 64 + 32 * i) * NP + 256);
        rv[i] = *(const u32x4*)(gbase + (size_t)((kt + 2) * 64 + 32 * i) * NP + 512);
      }
    }
    auto computeS = [&](int mp, int t2) -> f32x16 {
      f32x16 S;
#pragma unroll
      for (int i = 0; i < 16; i++) S[i] = SHIFT ? negM[mp] : 0.f;
#pragma unroll
      for (int s = 0; s < 2; s++) {
        bf16x8 kf = *(const bf16x8*)(Kc + (t2 * 32 + r) * 72 + mp * 32 + s * 16 + h * 8);
        S = mfma32(kf, qf[mp][s], S);
      }
      return S;
    };
    auto doExp = [&](f32x16& S, int mp) {
      float ps = 0.f;
#pragma unroll
      for (int i = 0; i < 16; i++) {
        float pv = fexp2(S[i]);
        ps += pv;
        S[i] = pv;
      }
      lsum[mp] += ps;
    };
    auto doPV = [&](bf16x8 pf0, bf16x8 pf1, int mp, int t2) {
#pragma unroll
      for (int dt = 0; dt < 2; dt++) {
        bf16x8 v0 = load_vfrag(Vc, 72, t2 * 32, dt * 32, lane);
        O[mp][dt] = mfma32(v0, pf0, O[mp][dt]);
        bf16x8 v1 = load_vfrag(Vc, 72, t2 * 32 + 16, dt * 32, lane);
        O[mp][dt] = mfma32(v1, pf1, O[mp][dt]);
      }
    };
    f32x16 Sa = computeS(0, 0);
    f32x16 Sb = computeS(0, 1);
    __builtin_amdgcn_sched_barrier(0);
    doExp(Sa, 0);
    bf16x8 pa0 = pack_p(Sa, 0), pa1 = pack_p(Sa, 1);
    __builtin_amdgcn_sched_barrier(0);
    doPV(pa0, pa1, 0, 0);
    Sa = computeS(1, 0);
    doExp(Sb, 0);
    bf16x8 pb0 = pack_p(Sb, 0), pb1 = pack_p(Sb, 1);
#pragma unroll
    for (int k = 0; k < 6; k++) {
      __builtin_amdgcn_sched_group_barrier(0x8, 1, 0);
      __builtin_amdgcn_sched_group_barrier(0x2, 7, 0);
    }
    __builtin_amdgcn_sched_barrier(0);
    doPV(pb0, pb1, 0, 1);
    Sb = computeS(1, 1);
    doExp(Sa, 1);
    pa0 = pack_p(Sa, 0); pa1 = pack_p(Sa, 1);
#pragma unroll
    for (int k = 0; k < 6; k++) {
      __builtin_amdgcn_sched_group_barrier(0x8, 1, 0);
      __builtin_amdgcn_sched_group_barrier(0x2, 7, 0);
    }
    __builtin_amdgcn_sched_barrier(0);
    doPV(pa0, pa1, 1, 0);
    doExp(Sb, 1);
    pb0 = pack_p(Sb, 0); pb1 = pack_p(Sb, 1);
#pragma unroll
    for (int k = 0; k < 4; k++) {
      __builtin_amdgcn_sched_group_barrier(0x8, 1, 0);
      __builtin_amdgcn_sched_group_barrier(0x2, 10, 0);
    }
    __builtin_amdgcn_sched_barrier(0);
    doPV(pb0, pb1, 1, 1);
    __builtin_amdgcn_sched_barrier(0);
    RAW_BARRIER();
  }
  }
  const float lam = p.ctab[l * 16 + 0];
  const float one_m_li = p.ctab[l * 16 + 1];
  const float l0 = lsum[0] + xhalf(lsum[0]);
  const float l1 = lsum[1] + xhalf(lsum[1]);
  const float inv0 = 1.f / l0, inv1 = lam / l1;
  float ss = 0.f;
#pragma unroll
  for (int dt = 0; dt < 2; dt++)
#pragma unroll
    for (int i = 0; i < 16; i++) {
      float o = O[0][dt][i] * inv0 - O[1][dt][i] * inv1;
      O[0][dt][i] = o;
      ss += o * o;
    }
  ss += xhalf(ss);
  const float rstd = rsqrtf(ss * (1.f / 64.f) + 1e-6f) * one_m_li;
  const size_t tok = (size_t)b * SEQ + qpos;
#pragma unroll
  for (int dt = 0; dt < 2; dt++)
#pragma unroll
    for (int gq = 0; gq < 4; gq++) {
      const int d0 = dt * 32 + 8 * gq + 4 * h;
      u32x2 gt = *(const u32x2*)(p.pbuf + tok * NP + 768 + hd * 64 + d0);
      f32x4 sb = *(const f32x4*)(p.subln_a + l * 64 + d0);
      float v0 = O[0][dt][4 * gq + 0] * rstd * sb[0] * bf_lo(gt[0]);
      float v1 = O[0][dt][4 * gq + 1] * rstd * sb[1] * bf_hi(gt[0]);
      float v2 = O[0][dt][4 * gq + 2] * rstd * sb[2] * bf_lo(gt[1]);
      float v3 = O[0][dt][4 * gq + 3] * rstd * sb[3] * bf_hi(gt[1]);
      u32x2 o = {pk2(v0, v1), pk2(v2, v3)};
      *(u32x2*)(p.ybuf + toff(tok, hd * 64 + d0)) = o;
    }
}

__device__ __forceinline__ void ret_decays(const Params& p, int l, int hd, float& lgf, float& lgb) {
  lgf = p.ctab[l * 16 + 2 + hd];
  lgb = p.ctab[l * 16 + 6 + hd];
}

__device__ __forceinline__ u32x4 scale_bf8(u32x4 v, float sc) {
  u32x4 o;
#pragma unroll
  for (int j = 0; j < 4; j++) o[j] = pk2(bf_lo(v[j]) * sc, bf_hi(v[j]) * sc);
  return o;
}

__device__ void retS_task(const Params& p_in, int l, int task, char* smem) {
  const Params p = opaque_params(p_in);
  const int tid = opaque_tid(), wave = tid >> 6, lane = tid & 63, r = lane & 31, h = lane >> 5;
  const int b = task >> 7, hd = (task >> 5) & 3, n = task & 31;
  u16* Kf = (u16*)smem;
  u16* Kb = Kf + 128 * 72;
  u16* Vs = Kb + 128 * 72;
  const u16* Pb = p.pbuf + ((size_t)b * SEQ + n * 128) * NP;
  float lgf, lgb;
  ret_decays(p, l, hd, lgf, lgb);
#pragma unroll
  for (int i = 0; i < 4; i++) {
    const int c = tid + 256 * i;
    const int row = c >> 3, ch = c & 7;
    u32x4 kv = *(const u32x4*)(Pb + (size_t)row * NP + 2816 + hd * 64 + ch * 8);
    const float df = fexp2(lgf * (float)(127 - row)), db = fexp2(lgb * (float)row);
    *(u32x4*)(Kf + row * 72 + ch * 8) = scale_bf8(kv, df);
    *(u32x4*)(Kb + row * 72 + ch * 8) = scale_bf8(kv, db);
  }
#pragma unroll
  for (int i = 0; i < 6; i++) {
    const int c = tid + 256 * i;
    const int row = c / 12, ch = c % 12;
    *(u32x4*)(Vs + row * 104 + ch * 8) = *(const u32x4*)(Pb + (size_t)row * NP + 3072 + hd * 96 + ch * 8);
  }
  __syncthreads();
  const int dir = wave >> 1, kkt = wave & 1;
  const u16* Kt = dir ? Kb : Kf;
  f32x16 acc[3];
#pragma unroll
  for (int c = 0; c < 3; c++)
#pragma unroll
    for (int i = 0; i < 16; i++) acc[c][i] = 0.f;
#pragma unroll
  for (int s = 0; s < 8; s++) {
    bf16x8 kfr = load_vfrag(Kt, 72, 16 * s, 32 * kkt, lane);
#pragma unroll
    for (int dt = 0; dt < 3; dt++) {
      bf16x8 vfr = load_vfrag(Vs, 104, 16 * s, 32 * dt, lane);
      acc[dt] = mfma32(vfr, kfr, acc[dt]);
    }
  }
  float* dst = p.state + ((((size_t)(b * 4 + hd) * 32 + n) * 2 + dir) * 4608);
  const int kk = 32 * kkt + r;
  if (kk < 48) {
#pragma unroll
    for (int dt = 0; dt < 3; dt++)
#pragma unroll
      for (int i = 0; i < 16; i++) {
        const int d = 32 * dt + (i & 3) + 8 * (i >> 2) + 4 * h;
        store_wt_f32(dst + d * 48 + kk, acc[dt][i]);
      }
  }
}

__device__ void retO_task(const Params& p_in, int l, int task, char* smem) {
  const Params p = opaque_params(p_in);
  const int tid = opaque_tid(), wave = tid >> 6, lane = tid & 63, r = lane & 31, h = lane >> 5;
  const int b = task >> 7, hd = (task >> 5) & 3, qblk = task & 31;
  u16* Ks = (u16*)smem;
  u16* Vs = Ks + 64 * 72;
  u16* RfT = Vs + 64 * 104;
  u16* RbT = RfT + 96 * 72;
  const u16* Pb = p.pbuf + (size_t)b * SEQ * NP;
  const int qpos = qblk * 128 + wave * 32 + r;
  float lgf, lgb;
  ret_decays(p, l, hd, lgf, lgb);
  const float nlgb = -lgb;
  {
    const u16* Pf = (const u16*)(p.state + (size_t)16 * 32 * 2 * 4608) + (((size_t)(b * 4 + hd) * 32 + qblk) * 2) * 4608;
#pragma unroll
    for (int j = 0; j < 3; j++) {
      const int c = tid + 256 * j;
      if (c < 576) {
        const int e = 8 * c;
        const int d = e / 48, kk = e % 48;
        *(u32x4*)(RfT + d * 72 + kk) = *(const u32x4*)(Pf + e);
        *(u32x4*)(RbT + d * 72 + kk) = *(const u32x4*)(Pf + 4608 + e);
      }
    }
  }
  bf16x8 qf[3];
#pragma unroll
  for (int s = 0; s < 3; s++) qf[s] = *(const bf16x8*)(Pb + (size_t)qpos * NP + 2560 + hd * 64 + s * 16 + h * 8);
  f32x16 O[3];
  __syncthreads();
  {
    const int iq = wave * 32 + r;
    const float sf = fexp2(lgf * (float)(iq + 1)), sb = fexp2(lgb * (float)(128 - iq));
#pragma unroll
    for (int dt = 0; dt < 3; dt++) {
      f32x16 X;
#pragma unroll
      for (int i = 0; i < 16; i++) X[i] = 0.f;
#pragma unroll
      for (int s = 0; s < 3; s++) {
        bf16x8 a = *(const bf16x8*)(RfT + (32 * dt + r) * 72 + 16 * s + 8 * h);
        X = mfma32(a, qf[s], X);
      }
#pragma unroll
      for (int i = 0; i < 16; i++) O[dt][i] = X[i] * sf;
#pragma unroll
      for (int i = 0; i < 16; i++) X[i] = 0.f;
#pragma unroll
      for (int s = 0; s < 3; s++) {
        bf16x8 a = *(const bf16x8*)(RbT + (32 * dt + r) * 72 + 16 * s + 8 * h);
        X = mfma32(a, qf[s], X);
      }
#pragma unroll
      for (int i = 0; i < 16; i++) O[dt][i] += X[i] * sb;
    }
  }
  const int krow = tid >> 3, kch = tid & 7;
  u32x4 rk[2], rv[3];
  int vrow[3], vch[3];
#pragma unroll
  for (int i = 0; i < 3; i++) {
    int c = tid + 256 * i;
    vrow[i] = c / 12;
    vch[i] = c % 12;
  }
  const u16* kbase = Pb + (size_t)krow * NP + 2816 + hd * 64 + kch * 8;
  const u16* vbase = Pb + 3072 + hd * 96;
  const int kt0 = 2 * qblk;
#pragma unroll
  for (int i = 0; i < 2; i++) rk[i] = *(const u32x4*)(kbase + (size_t)(kt0 * 64 + 32 * i) * NP);
#pragma unroll
  for (int i = 0; i < 3; i++) rv[i] = *(const u32x4*)(vbase + (size_t)(kt0 * 64 + vrow[i]) * NP + vch[i] * 8);
  for (int kt = kt0; kt < kt0 + 2; kt++) {
    __syncthreads();
#pragma unroll
    for (int i = 0; i < 2; i++) *(u32x4*)(Ks + (krow + 32 * i) * 72 + kch * 8) = rk[i];
#pragma unroll
    for (int i = 0; i < 3; i++) *(u32x4*)(Vs + vrow[i] * 104 + vch[i] * 8) = rv[i];
    __syncthreads();
    if (kt + 1 < kt0 + 2) {
#pragma unroll
      for (int i = 0; i < 2; i++) rk[i] = *(const u32x4*)(kbase + (size_t)((kt + 1) * 64 + 32 * i) * NP);
#pragma unroll
      for (int i = 0; i < 3; i++) rv[i] = *(const u32x4*)(vbase + (size_t)((kt + 1) * 64 + vrow[i]) * NP + vch[i] * 8);
    }
    bf16x8 pf[2][2];
#pragma unroll
    for (int t2 = 0; t2 < 2; t2++) {
      f32x16 S;
#pragma unroll
      for (int i = 0; i < 16; i++) S[i] = 0.f;
#pragma unroll
      for (int s = 0; s < 3; s++) {
        bf16x8 kf = *(const bf16x8*)(Ks + (t2 * 32 + r) * 72 + s * 16 + h * 8);
        S = mfma32(kf, qf[s], S);
      }
      const int kp0 = kt * 64 + t2 * 32 + 4 * h;
#pragma unroll
      for (int i = 0; i < 16; i++) {
        const int kp = kp0 + (i & 3) + 8 * (i >> 2);
        const float delta = (float)(qpos - kp);
        const float e = delta * (delta >= 0.f ? lgf : nlgb);
        S[i] = S[i] * fexp2(e);
      }
      pf[t2][0] = pack_p(S, 0);
      pf[t2][1] = pack_p(S, 1);
    }
#pragma unroll
    for (int t2 = 0; t2 < 2; t2++)
#pragma unroll
      for (int s2 = 0; s2 < 2; s2++)
#pragma unroll
        for (int dt = 0; dt < 3; dt++) {
          bf16x8 vf = load_vfrag(Vs, 104, t2 * 32 + s2 * 16, dt * 32, lane);
          O[dt] = mfma32(vf, pf[t2][s2], O[dt]);
        }
  }
  float ss = 0.f;
#pragma unroll
  for (int dt = 0; dt < 3; dt++)
#pragma unroll
    for (int i = 0; i < 16; i++) ss += O[dt][i] * O[dt][i];
  ss += xhalf(ss);
  const float rstd = rsqrtf(ss * (1.f / 96.f) + 1e-6f);
  const size_t tok = (size_t)b * SEQ + qpos;
#pragma unroll
  for (int dt = 0; dt < 3; dt++)
#pragma unroll
    for (int gq = 0; gq < 4; gq++) {
      const int d0 = dt * 32 + 8 * gq + 4 * h;
      u32x2 gt = *(const u32x2*)(p.pbuf + tok * NP + 3456 + hd * 96 + d0);
      f32x4 gn = *(const f32x4*)(p.gn_c + l * 96 + d0);
      float v0 = O[dt][4 * gq + 0] * rstd * gn[0] * bf_lo(gt[0]);
      float v1 = O[dt][4 * gq + 1] * rstd * gn[1] * bf_hi(gt[0]);
      float v2 = O[dt][4 * gq + 2] * rstd * gn[2] * bf_lo(gt[1]);
      float v3 = O[dt][4 * gq + 3] * rstd * gn[3] * bf_hi(gt[1]);
      u32x2 o = {pk2(v0, v1), pk2(v2, v3)};
      *(u32x2*)(p.ybuf + toff(tok, 640 + hd * 96 + d0)) = o;
    }
}


__device__ void retScan_task(const Params& p_in, int l, int task) {
  const Params p = opaque_params(p_in);
  const int tid = opaque_tid();
  const int half = task & 1, dir = (task >> 1) & 1, pair = task >> 2, hd = pair & 3;
  float lgf, lgb;
  ret_decays(p, l, hd, lgf, lgb);
  const float w = fexp2((dir ? lgb : lgf) * 128.f);
  const float* Sbase = p.state + ((size_t)pair * 32) * 2 * 4608 + (size_t)dir * 4608 + (size_t)half * 2304;
  u16* Pf = (u16*)(p.state + (size_t)16 * 32 * 2 * 4608) + ((size_t)pair * 32) * 2 * 4608 + (size_t)dir * 4608 + (size_t)half * 2304;
  const bool tail = tid < 64;
  f32x4 acc[3];
#pragma unroll
  for (int j = 0; j < 3; j++) acc[j] = (f32x4){0.f, 0.f, 0.f, 0.f};
#pragma unroll 8
  for (int i = 0; i < 32; i++) {
    const int m = dir ? 31 - i : i;
    const f32x4* src = (const f32x4*)(Sbase + (size_t)m * 2 * 4608) + tid;
    u16* dstp = Pf + (size_t)m * 2 * 4608;
#pragma unroll
    for (int j = 0; j < 3; j++) {
      if (j < 2 || tail) {
        f32x4 v = src[256 * j];
        u32x2 x = {pk2(acc[j][0], acc[j][1]), pk2(acc[j][2], acc[j][3])};
        *(u32x2*)(dstp + 4 * (tid + 256 * j)) = x;
        acc[j] = acc[j] * w + v;
      }
    }
  }
}

__device__ __forceinline__ void event_signal(unsigned* cnt) {
  asm volatile("s_waitcnt vmcnt(0)" ::: "memory");
  __syncthreads();
  if (opaque_tid() == 0) {
    (void)__hip_atomic_fetch_add(cnt, 1u, __ATOMIC_RELAXED, __HIP_MEMORY_SCOPE_AGENT);
  }
}
__device__ __forceinline__ void event_wait(unsigned* cnt, unsigned target) {
  if (opaque_tid() == 0) {
    unsigned sp = 0;
    while (__hip_atomic_load(cnt, __ATOMIC_RELAXED, __HIP_MEMORY_SCOPE_AGENT) < target) {
      __builtin_amdgcn_s_sleep(1);
      if (++sp > (1u << 24)) break;
    }
    __builtin_amdgcn_fence(__ATOMIC_ACQUIRE, "agent");
    asm volatile("s_waitcnt vmcnt(0)" ::: "memory");
  }
  __syncthreads();
}

__device__ void attnB_task(const Params& p_in, int l, int task, char* smem) {
  const Params p = opaque_params(p_in);
  const int tid = opaque_tid(), wave = tid >> 6, lane = tid & 63, r = lane & 31, h = lane >> 5;
  const int tblk = task & 1, r16 = (task >> 1) & 15, bh = task >> 5;
  const int b = bh / 6, hd = bh % 6;
  const u16* Pb = p.pbuf + (size_t)b * SEQ * NP;
  const int t0 = tblk * 128 + wave * 32;
  const int pos0 = r16 + 16 * t0;
  const int qpos = pos0 + 16 * r;
  bf16x8 qf[4];
#pragma unroll
  for (int s = 0; s < 4; s++) qf[s] = *(const bf16x8*)(Pb + (size_t)qpos * NP + 1024 + hd * 64 + s * 16 + h * 8);
  f32x16 O[2];
#pragma unroll
  for (int c = 0; c < 2; c++)
#pragma unroll
    for (int i = 0; i < 16; i++) O[c][i] = 0.f;
  float lsum = 0.f;
  float negM;
  {
    float q2 = 0.f;
#pragma unroll
    for (int s = 0; s < 4; s++)
#pragma unroll
      for (int j = 0; j < 8; j++) {
        float qv = __uint_as_float(((uint32_t)(unsigned short)qf[s][j]) << 16);
        q2 += qv * qv;
      }
    q2 += xhalf(q2);
    negM = -sqrtf(q2) * p.ctab[l * 16 + 11];
  }
  bf16x8 kf0[4], kf1[4];
  u32x4 rv0[4], rv1[4];
  auto unit_geom = [&](int u, int& g, int& lo) {
    int uu;
    if (u < 20) { g = 1; uu = u; }
    else if (u < 28) { g = 4; uu = u - 20; }
    else { g = 16; uu = u - 28; }
    lo = pos0 - 64 * g + g * 32 * uu;
  };
  auto prefetch = [&](int u, bf16x8 (&kf)[4], u32x4 (&rv)[4]) {
    int g, lo;
    unit_geom(u, g, lo);
    int kp = lo + g * r;
    kp = kp < 0 ? 0 : (kp > SEQ - 1 ? SEQ - 1 : kp);
    const u16* kb = Pb + (size_t)kp * NP + 1408 + hd * 64 + h * 8;
#pragma unroll
    for (int s = 0; s < 4; s++) kf[s] = *(const bf16x8*)(kb + s * 16);
#pragma unroll
    for (int i = 0; i < 4; i++) {
      int c = lane + 64 * i;
      int row = c >> 3, ch = c & 7;
      int vp = lo + g * row;
      vp = vp < 0 ? 0 : (vp > SEQ - 1 ? SEQ - 1 : vp);
      rv[i] = *(const u32x4*)(Pb + (size_t)vp * NP + 1792 + hd * 64 + ch * 8);
    }
  };
  auto body = [&](int u, bf16x8 (&kf)[4], u32x4 (&rv)[4], u16* Vb) {
    int g, lo;
    unit_geom(u, g, lo);
#pragma unroll
    for (int i = 0; i < 4; i++) {
      int c = lane + 64 * i;
      *(u32x4*)(Vb + (c >> 3) * 72 + (c & 7) * 8) = rv[i];
    }
    f32x16 S;
#pragma unroll
    for (int i = 0; i < 16; i++) S[i] = negM;
#pragma unroll
    for (int s = 0; s < 4; s++) S = mfma32(kf[s], qf[s], S);
    if (u + 2 < 33) prefetch(u + 2, kf, rv);
    const int W = 64 * g;
    const int lob = qpos - W > 0 ? qpos - W : 0;
    const int hib = qpos + W < SEQ - 1 ? qpos + W : SEQ - 1;
    const unsigned rng = (unsigned)(hib - lob);
    const int base = lo + 4 * g * h - lob;
    float ps = 0.f;
#pragma unroll
    for (int i = 0; i < 16; i++) {
      const bool valid = (unsigned)(base + g * ((i & 3) + 8 * (i >> 2))) <= rng;
      float pv = valid ? fexp2(S[i]) : 0.f;
      ps += pv;
      S[i] = pv;
    }
    lsum += ps;
    bf16x8 pf0 = pack_p(S, 0), pf1 = pack_p(S, 1);
    asm volatile("s_waitcnt lgkmcnt(0)" ::: "memory");
#pragma unroll
    for (int dt = 0; dt < 2; dt++) {
      bf16x8 v0 = load_vfrag(Vb, 72, 0, dt * 32, lane);
      O[dt] = mfma32(v0, pf0, O[dt]);
      bf16x8 v1 = load_vfrag(Vb, 72, 16, dt * 32, lane);
      O[dt] = mfma32(v1, pf1, O[dt]);
    }
  };
  u16* Vw0 = (u16*)smem + wave * 2 * 32 * 72;
  u16* Vw1 = Vw0 + 32 * 72;
  prefetch(0, kf0, rv0);
  prefetch(1, kf1, rv1);
  for (int u = 0; u < 33; u += 2) {
    body(u, kf0, rv0, Vw0);
    if (u + 1 < 33) body(u + 1, kf1, rv1, Vw1);
  }
  const float lt = lsum + xhalf(lsum);
  const float inv = 1.f / lt;
  const size_t tok = (size_t)b * SEQ + qpos;
#pragma unroll
  for (int dt = 0; dt < 2; dt++)
#pragma unroll
    for (int gq = 0; gq < 4; gq++) {
      const int d0 = dt * 32 + 8 * gq + 4 * h;
      u32x2 gt = *(const u32x2*)(p.pbuf + tok * NP + 2176 + hd * 64 + d0);
      float v0 = O[dt][4 * gq + 0] * inv * bf_lo(gt[0]);
      float v1 = O[dt][4 * gq + 1] * inv * bf_hi(gt[0]);
      float v2 = O[dt][4 * gq + 2] * inv * bf_lo(gt[1]);
      float v3 = O[dt][4 * gq + 3] * inv * bf_hi(gt[1]);
      u32x2 o = {pk2(v0, v1), pk2(v2, v3)};
      *(u32x2*)(p.ybuf + toff(tok, 256 + hd * 64 + d0)) = o;
    }
}

__device__ void phase_mix(const Params& p, int l, char* smem, int bid, int nb) {
  unsigned* ev = p.bar + 0;
  const bool xs = (opq(nb) & 7) == 0;
  const int xcd = xs ? (bid & 7) : 0, jl = xs ? (bid >> 3) : bid, nj = xs ? (nb >> 3) : nb;
  const int nS = xs ? 64 : 512, nB = xs ? 96 : 768;
  const bool noshiftA = p.ctab[l * 16 + 12] <= 64.f;
  for (int li = jl; li < nS; li += nj) { retS_task(p, l, xcd * nS + li, smem); event_signal(ev); __syncthreads(); }
  unsigned* ev2 = p.bar + 64;
  {
    const int nscan = xs ? 8 : 64;
    const int first = nj - nscan;
    if (jl >= first && jl - first < nscan) {
      event_wait(ev, 512u * (unsigned)(l + 1));
      retScan_task(p, l, xcd * nscan + (jl - first));
      asm volatile("s_waitcnt vmcnt(0)" ::: "memory");
      __syncthreads();
      if (opaque_tid() == 0) {
        __builtin_amdgcn_fence(__ATOMIC_RELEASE, "agent");
        asm volatile("s_waitcnt vmcnt(0)" ::: "memory");
        (void)__hip_atomic_fetch_add(ev2, 1u, __ATOMIC_RELAXED, __HIP_MEMORY_SCOPE_AGENT);
      }
      __syncthreads();
    }
  }
  for (int li = jl; li < nS; li += nj) {
    for (int rep = 0; rep < opq(REP_A); rep++) {
      if (noshiftA) attnA_task<false>(p, l, xcd * nS + li, smem); else attnA_task<true>(p, l, xcd * nS + li, smem);
      __syncthreads();
    }
  }
  for (int li = jl; li < nB; li += nj) {
    for (int rep = 0; rep < opq(REP_B); rep++) { attnB_task(p, l, xcd * nB + li, smem); __syncthreads(); }
  }
  event_wait(ev2, 64u * (unsigned)(l + 1));
  for (int li = jl; li < nS; li += nj) {
    for (int rep = 0; rep < opq(REP_C); rep++) { retO_task(p, l, xcd * nS + li, smem); __syncthreads(); }
  }
}

#define XB_TMO      128
#define XB_XCNT(j)  (256  + 64 * (j))
#define XB_XSUB(j)  (1280 + 64 * (j))
#define XB_XGEN(j)  (2304 + 64 * (j))
#define XB_TOP      3328
#define XB_TOPGEN   3392
#define XCD_BAR_WORDS 3456
#define XB_SPIN_CAP (1u << 22)
#define LAS __attribute__((address_space(3)))
__device__ __forceinline__ unsigned xb_ld(unsigned* p) { return __hip_atomic_load(p, __ATOMIC_RELAXED, __HIP_MEMORY_SCOPE_AGENT); }
__device__ __forceinline__ unsigned xb_add(unsigned* p, unsigned v) { return __hip_atomic_fetch_add(p, v, __ATOMIC_RELAXED, __HIP_MEMORY_SCOPE_AGENT); }
__device__ __forceinline__ unsigned xb_xcc_id() { return (unsigned)__builtin_amdgcn_s_getreg((3 << 11) | 20) & 0xFu; }
#define XB_SPIN(cond, bar) do { unsigned _sp = 0; while (cond) { __builtin_amdgcn_s_sleep(1); \
    if ((++_sp & 255u) == 0u) { if (xb_ld(&(bar)[XB_TMO])) break; if (_sp > XB_SPIN_CAP) { atomicAdd(&(bar)[XB_TMO], 1u); break; } } } } while (0)
struct XcdBarrier { unsigned* bar; unsigned x; volatile LAS unsigned* st; };
__device__ __forceinline__ XcdBarrier xcd_barrier_post(unsigned* bar, volatile LAS unsigned* st) {
  XcdBarrier b; b.bar = bar; b.x = xb_xcc_id(); b.st = st;
  if (opaque_tid() == 0) (void)xb_add(&bar[XB_XCNT(b.x)], 1u);
  return b;
}
__device__ __forceinline__ void xcd_barrier_complete(unsigned* bar, unsigned x, unsigned& nloc, unsigned& nx) {
  const unsigned G = gridDim.x * gridDim.y * gridDim.z;
  unsigned sum, cnt, mine, sp = 0u;
  for (;;) {
    sum = 0u; cnt = 0u; mine = 0u;
#pragma unroll
    for (unsigned j = 0; j < 16; ++j) { const unsigned c = xb_ld(&bar[XB_XCNT(j)]); sum += c; cnt += (c > 0u) ? 1u : 0u; mine = (j == x) ? c : mine; }
    if (sum == G) break;
    __builtin_amdgcn_s_sleep(1);
    if ((++sp & 255u) == 0u) { if (xb_ld(&bar[XB_TMO])) break; if (sp > XB_SPIN_CAP) { atomicAdd(&bar[XB_TMO], 1u); break; } }
  }
  nloc = mine > 0u ? mine : 1u; nx = cnt > 0u ? cnt : 1u;
}
__device__ __forceinline__ void xcd_barrier(const XcdBarrier& b) {
  asm volatile("s_waitcnt vmcnt(0)" ::: "memory");
  __syncthreads();
  if (opaque_tid() == 0) {
    unsigned* bar = b.bar;
    __builtin_amdgcn_s_waitcnt(0);
    unsigned nloc = b.st[0], nx = b.st[1];
    if (nloc == 0u) { xcd_barrier_complete(bar, b.x, nloc, nx); b.st[0] = nloc; b.st[1] = nx; }
    const unsigned old = xb_add(&bar[XB_XSUB(b.x)], 1u);
    const unsigned gen = old / nloc;
    if (old + 1u == (gen + 1u) * nloc) {
      __builtin_amdgcn_fence(__ATOMIC_RELEASE, "agent");
      asm volatile("s_waitcnt vmcnt(0)" ::: "memory");
      const unsigned og = xb_add(&bar[XB_TOP], 1u);
      const unsigned tg = og / nx;
      if (og + 1u == (tg + 1u) * nx) xb_add(&bar[XB_TOPGEN], 1u);
      else XB_SPIN(xb_ld(&bar[XB_TOPGEN]) == tg, bar);
      __builtin_amdgcn_fence(__ATOMIC_ACQUIRE, "agent");
      xb_add(&bar[XB_XGEN(b.x)], 1u);
      asm volatile("s_waitcnt vmcnt(0)" ::: "memory");
    } else {
      XB_SPIN(xb_ld(&bar[XB_XGEN(b.x)]) == gen, bar);
      __builtin_amdgcn_fence(__ATOMIC_ACQUIRE, "agent");
      asm volatile("s_waitcnt vmcnt(0)" ::: "memory");
    }
  }
  __syncthreads();
}

#if USE_COOP
__global__ void __launch_bounds__(256, 2) mega(Params p, int ph_lo, int ph_hi, int coop) {
  __shared__ __attribute__((aligned(16))) char smem[SMEM_BYTES];
  __shared__ uint4 xb_words;
  const int bid = blockIdx.x, nb = gridDim.x;
  if (threadIdx.x == 0) xb_words = make_uint4(0u, 0u, 0u, 0u);
  __syncthreads();
  if (coop) (void)xcd_barrier_post(p.bar, (volatile LAS unsigned*)&xb_words);
  if (ph_hi > 1000) cg::this_grid().sync();
  for (int ph = ph_lo; ph < ph_hi; ph++) {
    if (ph == 0) { for (int rep = 0; rep < opq(REP_P0); rep++) phase0(p, smem, bid, nb); }
    else if (ph == 1) phase0b(p, bid, nb);
    else {
      const int l = (ph - 2) >> 2, sub = (ph - 2) & 3;
      const float* xin = l == 0 ? p.x : p.out;
      if (sub == 0) { for (int rep = 0; rep < opq(REP_N); rep++) phase_norm(p, l, xin, bid, nb); }
      else if (sub == 1) { for (int rep = 0; rep < opq(REP_G0); rep++) phase_gemm<0>(p, l, xin, p.out, smem, bid, nb); }
      else if (sub == 2) phase_mix(p, l, smem, bid, nb);
      else {
        for (int rep = 1; rep < opq(REP_G1); rep++) phase_gemm<1>(p, l, xin, (float*)p.pbuf, smem, bid, nb);
        phase_gemm<1>(p, l, xin, p.out, smem, bid, nb);
      }
    }
    if (coop && ph + 1 < ph_hi) {
      XcdBarrier xb;
      xb.bar = p.bar; xb.x = xb_xcc_id(); xb.st = (volatile LAS unsigned*)&xb_words;
      xcd_barrier(xb);
    }
  }
}
#else
__global__ void __launch_bounds__(256, 2) k_phase0(Params p) {
  __shared__ __attribute__((aligned(16))) char smem[SMEM_BYTES];
  phase0(p, smem, blockIdx.x, gridDim.x);
}
__global__ void __launch_bounds__(256, 2) k_phase0b(Params p) { phase0b(p, blockIdx.x, gridDim.x); }
__global__ void __launch_bounds__(256, 2) k_norm(Params p, int l) {
  phase_norm(p, l, l == 0 ? p.x : p.out, blockIdx.x, gridDim.x);
}
template <int MODE>
__global__ void __launch_bounds__(256, 2) k_gemm(Params p, int l) {
  __shared__ __attribute__((aligned(16))) char smem[SMEM_BYTES];
  phase_gemm<MODE>(p, l, l == 0 ? p.x : p.out, p.out, smem, blockIdx.x, gridDim.x);
}
template <int WHICH>
__global__ void __launch_bounds__(256, WHICH == 0 ? 1 : 2) k_mix(Params p, int l) {
  __shared__ __attribute__((aligned(16))) char smem[SMEM_BYTES];
  if (WHICH == 0) { for (int t = blockIdx.x; t < 512; t += gridDim.x) { attnA_task<true>(p, l, t, smem); __syncthreads(); } }
  if (WHICH == 1) { for (int t = blockIdx.x; t < 512; t += gridDim.x) { retS_task(p, l, t, smem); __syncthreads(); } }
  if (WHICH == 3) { for (int t = blockIdx.x; t < 512; t += gridDim.x) { retO_task(p, l, t, smem); __syncthreads(); } }
  if (WHICH == 2) { for (int t = blockIdx.x; t < 768; t += gridDim.x) { attnB_task(p, l, t, smem); __syncthreads(); } }
}
#endif

extern "C" void kernel_launch(void* const* d_in, const int* in_sizes, int n_in, void* d_out, int out_size,
                              void* d_ws, size_t ws_size, hipStream_t stream) {
  Params p{};
  p.x = (const float*)d_in[0]; p.c = (const float*)d_in[1]; p.norm_g = (const float*)d_in[2];
  p.w_ada = (const float*)d_in[3]; p.b_ada = (const float*)d_in[4]; p.w_in = (const float*)d_in[5];
  p.w_out = (const float*)d_in[6]; p.qn_a = (const float*)d_in[7]; p.kn_a = (const float*)d_in[8];
  p.lq1 = (const float*)d_in[9]; p.lk1 = (const float*)d_in[10]; p.lq2 = (const float*)d_in[11];
  p.lk2 = (const float*)d_in[12]; p.subln_a = (const float*)d_in[13]; p.qn_b = (const float*)d_in[14];
  p.kn_b = (const float*)d_in[15]; p.ret_decay = (const float*)d_in[16]; p.gn_c = (const float*)d_in[17];
  p.out = (float*)d_out;
  char* ws = (char*)d_ws;
  size_t off = 0;
  auto take = [&](size_t bytes) { char* q = ws + off; off += (bytes + 255) & ~(size_t)255; return q; };
  p.wt_in = (u16*)take((size_t)4 * NP * 1024 * 2);
  p.wt_out = (u16*)take((size_t)4 * 1024 * 1024 * 2);
  p.hbuf = (u16*)take((size_t)NTOK * 1024 * 2);
  p.pbuf = (u16*)take((size_t)NTOK * NP * 2);
  p.ybuf = (u16*)take((size_t)NTOK * 1024 * 2);
  p.modp = (float*)take((size_t)16 * 49152 * 4);
  p.mod = (float*)take((size_t)49152 * 4);
  p.rope = (float*)take((size_t)4096 * 72 * 4);
  p.bar = (unsigned*)take((size_t)XCD_BAR_WORDS * 4);
  p.ctab = (float*)take(64 * 4);
  p.state = (float*)p.hbuf;

#if USE_COOP
  static int grid_blocks = 0;
  if (!grid_blocks) {
    int dev = 0, cus = 0, per_cu = 0;
    (void)hipGetDevice(&dev);
    (void)hipDeviceGetAttribute(&cus, hipDeviceAttributeMultiprocessorCount, dev);
    (void)hipOccupancyMaxActiveBlocksPerMultiprocessor(&per_cu, mega, 256, 0);
    if (per_cu < 1) per_cu = 1;
    if (per_cu > 2) per_cu = 2;
    grid_blocks = cus * per_cu;
  }
  (void)hipMemsetAsync(p.bar, 0, (size_t)XCD_BAR_WORDS * 4, stream);
  int lo = 0, hi = 18, coop = 1;
  void* args[] = {&p, &lo, &hi, &coop};
  hipError_t e = hipLaunchCooperativeKernel((void*)mega, dim3(grid_blocks), dim3(256), args, 0, stream);
  if (e != hipSuccess) fprintf(stderr, "cooperative launch failed: %s (grid %d)\n", hipGetErrorString(e), grid_blocks);
#else
  const int G = 512;
  k_phase0<<<G, 256, 0, stream>>>(p);
  k_phase0b<<<G, 256, 0, stream>>>(p);
  for (int l = 0; l < 4; l++) {
    k_norm<<<G, 256, 0, stream>>>(p, l);
    k_gemm<0><<<G, 256, 0, stream>>>(p, l);
    k_mix<0><<<G, 256, 0, stream>>>(p, l);
    k_mix<1><<<G, 256, 0, stream>>>(p, l);
    k_mix<3><<<G, 256, 0, stream>>>(p, l);
    k_mix<2><<<G, 256, 0, stream>>>(p, l);
    k_gemm<1><<<G, 256, 0, stream>>>(p, l);
  }
#endif
}
```

```cpp
#include <hip/hip_runtime.h>
#include <hip/hip_cooperative_groups.h>
#include <stdint.h>
#include <stdio.h>
namespace cg = cooperative_groups;

#ifndef REP_G0
#define REP_G0 1
#endif
#ifndef REP_G1
#define REP_G1 1
#endif
#ifndef REP_A
#define REP_A 1
#endif
#ifndef REP_B
#define REP_B 1
#endif
#ifndef REP_C
#define REP_C 1
#endif
#ifndef REP_N
#define REP_N 1
#endif
#ifndef REP_P0
#define REP_P0 1
#endif
#ifndef USE_COOP
#define USE_COOP 1
#endif

typedef unsigned short u16;
typedef short bf16x8 __attribute__((ext_vector_type(8)));
typedef short s16x4 __attribute__((ext_vector_type(4)));
typedef float f32x16 __attribute__((ext_vector_type(16)));
typedef float f32x4 __attribute__((ext_vector_type(4)));
typedef float f32x2 __attribute__((ext_vector_type(2)));
typedef unsigned int u32x4 __attribute__((ext_vector_type(4)));
typedef unsigned int u32x2 __attribute__((ext_vector_type(2)));
typedef __bf16 bf16v2 __attribute__((ext_vector_type(2)));

constexpr int NP = 3840;
constexpr int SEQ = 4096;
constexpr int NTOK = 16384;
constexpr float LOG2E = 1.4426950408889634f;
constexpr int SMEM_BYTES = 73728;

struct Params {
  const float *x, *c, *norm_g, *w_ada, *b_ada, *w_in, *w_out, *qn_a, *kn_a, *lq1, *lk1, *lq2, *lk2,
      *subln_a, *qn_b, *kn_b, *ret_decay, *gn_c;
  float* out;
  u16 *wt_in, *wt_out, *hbuf, *pbuf, *ybuf;
  float *modp, *mod, *rope, *state, *ctab;
  unsigned* bar;
};


template <typename T>
__device__ __forceinline__ void launder(T*& ptr) {
  auto g = (__attribute__((address_space(1))) T*)ptr;
  asm volatile("" : "+s"(g));
  ptr = (T*)g;
}
__device__ __forceinline__ Params opaque_params(const Params& p) {
  Params q = p;
  launder(q.x); launder(q.c); launder(q.norm_g); launder(q.w_ada); launder(q.b_ada); launder(q.w_in); launder(q.w_out);
  launder(q.qn_a); launder(q.kn_a); launder(q.lq1); launder(q.lk1); launder(q.lq2); launder(q.lk2); launder(q.subln_a);
  launder(q.qn_b); launder(q.kn_b); launder(q.ret_decay); launder(q.gn_c); launder(q.out);
  launder(q.wt_in); launder(q.wt_out); launder(q.hbuf); launder(q.pbuf); launder(q.ybuf);
  launder(q.modp); launder(q.mod); launder(q.rope); launder(q.state); launder(q.ctab); launder(q.bar);
  return q;
}

typedef __attribute__((address_space(1))) unsigned long long gu64;
typedef __attribute__((address_space(1))) unsigned int gu32;
__device__ __forceinline__ void store_wt_f32(float* ptr, float v) {
  __hip_atomic_store((gu32*)ptr, __float_as_uint(v), __ATOMIC_RELAXED, __HIP_MEMORY_SCOPE_AGENT);
}

__device__ __forceinline__ size_t toff(size_t row, int k) {
  return ((row >> 1) * 32 + (size_t)(k >> 5)) * 64 + (row & 1) * 32 + (k & 31);
}
__device__ __forceinline__ uint32_t pk2(float a, float b) {
  f32x2 v = {a, b};
  bf16v2 r = __builtin_convertvector(v, bf16v2);
  return __builtin_bit_cast(uint32_t, r);
}
__device__ __forceinline__ float bf_lo(uint32_t u) { return __uint_as_float(u << 16); }
__device__ __forceinline__ float bf_hi(uint32_t u) { return __uint_as_float(u & 0xffff0000u); }
__device__ __forceinline__ float fexp2(float x) { return __builtin_amdgcn_exp2f(x); }
__device__ __forceinline__ float xhalf(float v) { return __shfl_xor(v, 32); }
__device__ __forceinline__ float silu_f(float v) { return v * __builtin_amdgcn_rcpf(1.f + __expf(-v)); }

#define LDSP __attribute__((address_space(3)))
#define RAW_BARRIER() do { asm volatile("s_waitcnt lgkmcnt(0)" ::: "memory"); __builtin_amdgcn_s_barrier(); } while (0)
__device__ __forceinline__ int opaque_tid() {
  int t = threadIdx.x;
  asm volatile("" : "+v"(t));
  return t;
}
__device__ __forceinline__ int opq(int v) {
  asm volatile("" : "+s"(v));
  return v;
}
__device__ __forceinline__ f32x16 mfma32(bf16x8 a, bf16x8 b, f32x16 c) {
  return __builtin_amdgcn_mfma_f32_32x32x16_bf16(a, b, c, 0, 0, 0);
}

__device__ __forceinline__ bf16x8 load_vfrag(const u16* Vs, int pitch, int key0, int d0, int lane) {
  int G = lane >> 4, i = lane & 15;
  int row = key0 + 4 * (G >> 1) + (i >> 2);
  int col = d0 + 16 * (G & 1) + 4 * (i & 3);
  const u16* a0 = Vs + row * pitch + col;
  const u16* a1 = a0 + 8 * pitch;
  s16x4 lo = __builtin_amdgcn_ds_read_tr16_b64_v4i16((__attribute__((address_space(3))) s16x4*)a0);
  s16x4 hi = __builtin_amdgcn_ds_read_tr16_b64_v4i16((__attribute__((address_space(3))) s16x4*)a1);
  bf16x8 r;
  r[0] = lo[0]; r[1] = lo[1]; r[2] = lo[2]; r[3] = lo[3];
  r[4] = hi[0]; r[5] = hi[1]; r[6] = hi[2]; r[7] = hi[3];
  return r;
}

__device__ __forceinline__ bf16x8 pack_p(const f32x16& s, int s2) {
  u32x4 w;
  w[0] = pk2(s[8 * s2 + 0], s[8 * s2 + 1]);
  w[1] = pk2(s[8 * s2 + 2], s[8 * s2 + 3]);
  w[2] = pk2(s[8 * s2 + 4], s[8 * s2 + 5]);
  w[3] = pk2(s[8 * s2 + 6], s[8 * s2 + 7]);
  return __builtin_bit_cast(bf16x8, w);
}

__device__ void phase0(const Params& p_in, char* smem, int bid, int nb) {
  const Params p = opaque_params(p_in);
  const int tid = opaque_tid();
  const int NT_IN = 4 * 16 * 30, NT_OUT = 4 * 16 * 8, NT_ADA = 768, NT_ROPE = 576;
  for (int t = bid; t < NT_IN + NT_OUT + NT_ADA + NT_ROPE; t += nb) {
    if (t < NT_IN + NT_OUT) {
      float* tile = (float*)smem;
      const bool isin = t < NT_IN;
      const int tt = isin ? t : t - NT_IN;
      const int ntn = isin ? 30 : 8;
      const int l = tt / (16 * ntn);
      const int rem = tt % (16 * ntn);
      const int kt = rem / ntn, nt = rem % ntn;
      const int ncols = isin ? 3712 : 1024;
      const float* src = isin ? p.w_in + (size_t)l * 1024 * 3712 : p.w_out + (size_t)l * 1024 * 1024;
      const int np = nt * 128 + (tid & 127);
      int col = np;
      if (isin) {
        if (np >= 3072) col = np - 128;
        else if (np >= 2560) {
          int q = np - 2560;
          int region = q >> 8, hh = (q & 255) >> 6, d = q & 63;
          col = d < 48 ? 2560 + region * 192 + hh * 48 + d : -1;
        }
      }
      const float* sp = src + (size_t)(kt * 64 + (tid >> 7)) * ncols + (col >= 0 ? col : 0);
      float vals[32];
#pragma unroll
      for (int i = 0; i < 32; i++) vals[i] = __builtin_nontemporal_load(sp + (size_t)(2 * i) * ncols);
#pragma unroll
      for (int i = 0; i < 32; i++) tile[(2 * i + (tid >> 7)) * 129 + (tid & 127)] = col >= 0 ? vals[i] : 0.f;
      __syncthreads();
      {
        const int n = tid >> 1, ks = (tid & 1) * 32;
        u16* wbase = isin ? p.wt_in + (size_t)l * NP * 1024 : p.wt_out + (size_t)l * 1024 * 1024;
        const size_t wrow = (size_t)nt * 128 + n;
#pragma unroll
        for (int q4 = 0; q4 < 4; q4++) {
          uint32_t w[4];
#pragma unroll
          for (int j = 0; j < 4; j++)
            w[j] = pk2(tile[(ks + 8 * q4 + 2 * j) * 129 + n], tile[(ks + 8 * q4 + 2 * j + 1) * 129 + n]);
          u32x4 wv = {w[0], w[1], w[2], w[3]};
          *(u32x4*)(wbase + toff(wrow, kt * 64 + ks + 8 * q4)) = wv;
        }
      }
      __syncthreads();
    } else if (t < NT_IN + NT_OUT + NT_ADA) {
      const int tt = t - (NT_IN + NT_OUT);
      const int l = tt / 192;
      const int rem = tt % 192;
      const int cb = rem / 16, kc = rem % 16;
      float* cs = (float*)smem;
      {
        int b = tid >> 6, kk = tid & 63;
        float cv = p.c[b * 1024 + kc * 64 + kk];
        cs[tid] = cv / (1.f + expf(-cv));
      }
      __syncthreads();
      const int col = cb * 256 + tid;
      float a0 = 0.f, a1 = 0.f, a2 = 0.f, a3 = 0.f;
      const float* w = p.w_ada + ((size_t)l * 1024 + kc * 64) * 3072 + col;
#pragma unroll 8
      for (int kk = 0; kk < 64; kk++) {
        float wv = __builtin_nontemporal_load(w + (size_t)kk * 3072);
        a0 += cs[kk] * wv;
        a1 += cs[64 + kk] * wv;
        a2 += cs[128 + kk] * wv;
        a3 += cs[192 + kk] * wv;
      }
      if (kc == 0) {
        float bv = p.b_ada[l * 3072 + col];
        a0 += bv; a1 += bv; a2 += bv; a3 += bv;
      }
      float* mp = p.modp + ((size_t)(kc * 4 + l) * 4) * 3072 + col;
      mp[0] = a0; mp[3072] = a1; mp[2 * 3072] = a2; mp[3 * 3072] = a3;
      __syncthreads();
    } else {
      const int tt = t - (NT_IN + NT_OUT + NT_ADA);
      const int e = tt * 256 + tid;
      if (tt == 0 && tid < 4) {
        const int l = tid;
        float d1 = 0.f, d2 = 0.f, ka = 0.f, kb = 0.f;
        for (int j = 0; j < 32; j++) {
          d1 += p.lq1[l * 32 + j] * p.lk1[l * 32 + j];
          d2 += p.lq2[l * 32 + j] * p.lk2[l * 32 + j];
          ka = fmaxf(ka, fabsf(p.kn_a[l * 32 + j]));
        }
        for (int j = 0; j < 64; j++) kb = fmaxf(kb, fabsf(p.kn_b[l * 64 + j]));
        const float lam_init = 0.8f - 0.6f * expf(-0.3f * (float)l);
        float* ct = p.ctab + l * 16;
        ct[0] = expf(d1) - expf(d2) + lam_init;
        ct[1] = 1.f - lam_init;
        for (int hd = 0; hd < 4; hd++) {
          const float xf = p.ret_decay[(l * 2 + 0) * 4 + hd], xb = p.ret_decay[(l * 2 + 1) * 4 + hd];
          ct[2 + hd] = -log1pf(expf(-xf)) * LOG2E;
          ct[6 + hd] = -log1pf(expf(-xb)) * LOG2E;
        }
        float qa = 0.f;
        for (int j = 0; j < 32; j++) qa = fmaxf(qa, fabsf(p.qn_a[l * 32 + j]));
        ct[10] = ka * 5.656854249492381f * 1.01f;
        ct[12] = qa * 5.656854249492381f * 0.17677669529663687f * LOG2E * 1.01f * ct[10];
        ct[11] = kb * 8.f * 1.01f;
      }
      if (e < 4096 * 36) {
        int pos = e / 36, j = e % 36;
        float expo;
        if (j < 4) expo = -(float)j * (18.931568569324174f / 4.f);
        else if (j < 12) expo = -(float)(j - 4) * (18.931568569324174f / 8.f);
        else expo = -(float)(j - 12) * (13.287712379549449f / 24.f);
        float inv = exp2f(expo);
        float ang = (float)pos * inv;
        double rev = (double)ang * 0.15915494309189535;
        rev -= rint(rev);
        float rf = (float)(rev * 6.283185307179586);
        p.rope[2 * e] = __cosf(rf);
        p.rope[2 * e + 1] = __sinf(rf);
      }
    }
  }
}

__device__ void phase0b(const Params& p_in, int bid, int nb) {
  const Params p = opaque_params(p_in);
  for (int idx = bid * 256 + opaque_tid(); idx < 49152; idx += nb * 256) {
    float s = 0.f;
#pragma unroll
    for (int kc = 0; kc < 16; kc++) s += p.modp[(size_t)kc * 49152 + idx];
    p.mod[idx] = s;
  }
}

__device__ void phase_norm(const Params& p_in, int l, const float* xin, int bid, int nb) {
  const Params p = opaque_params(p_in);
  const int tid = opaque_tid(), wave = tid >> 6, lane = tid & 63;
  for (int grp = bid * 4 + wave; grp < NTOK / 8; grp += nb * 4) {
    const int row0 = grp * 8;
    const int b = row0 >> 12;
    const float* mo = p.mod + (size_t)(l * 4 + b) * 3072;
    const float* g = p.norm_g + l * 1024;
    f32x4 gm[4], sh[4];
#pragma unroll
    for (int i = 0; i < 4; i++) {
      const int col = i * 256 + lane * 4;
      f32x4 gv = *(const f32x4*)(g + col);
      f32x4 sc = *(const f32x4*)(mo + 1024 + col);
      sh[i] = *(const f32x4*)(mo + col);
      gm[i] = gv * (1.f + sc);
    }
#pragma unroll 2
    for (int k = 0; k < 8; k++) {
      const int row = row0 + k;
      const float* xr = xin + (size_t)row * 1024;
      f32x4 v[4];
      float ss = 0.f;
#pragma unroll
      for (int i = 0; i < 4; i++) {
        v[i] = __builtin_nontemporal_load((const f32x4*)(xr + i * 256 + lane * 4));
        ss += v[i][0] * v[i][0] + v[i][1] * v[i][1] + v[i][2] * v[i][2] + v[i][3] * v[i][3];
      }
#pragma unroll
      for (int o = 32; o >= 1; o >>= 1) ss += __shfl_xor(ss, o);
      const float rstd = rsqrtf(ss * (1.f / 1024.f) + 1e-6f);
#pragma unroll
      for (int i = 0; i < 4; i++) {
        const int col = i * 256 + lane * 4;
        f32x4 y = v[i] * rstd * gm[i] + sh[i];
        u32x2 o = {pk2(y[0], y[1]), pk2(y[2], y[3])};
        *(u32x2*)(p.hbuf + toff((size_t)row, col)) = o;
      }
    }
  }
}

template <int MODE>
__device__ void phase_gemm(const Params& p_in, int l, const float* xin, float* outp, char* smem, int bid, int nb) {
  const Params p = opaque_params(p_in);
  const int tid = opaque_tid(), wave = tid >> 6, lane = tid & 63, r = lane & 31, h = lane >> 5;
  const int wm = wave >> 1, wn = wave & 1;
  const u16* A = MODE == 0 ? p.hbuf : p.ybuf;
  const u16* Bt = MODE == 0 ? p.wt_in + (size_t)l * NP * 1024 : p.wt_out + (size_t)l * 1024 * 1024;
  constexpr int NTN = MODE == 0 ? 30 : 8;
  constexpr int ntiles = 64 * NTN;
  const bool xs = (opq(nb) & 7) == 0;
  const int xcd = xs ? (bid & 7) : 0, jl = xs ? (bid >> 3) : bid, nj = xs ? (nb >> 3) : nb;
  const int per_x = xs ? ntiles / 8 : ntiles;
  for (int li = jl; li < per_x; li += nj) {
    int mt, nt;
    if (xs) {
      if (MODE == 0) {
        const int rect = li / 60, within = li % 60;
        mt = 8 * xcd + 4 * (rect >> 1) + (within & 3);
        nt = 15 * ((rect & 1) ^ ((rect >> 1) & 1)) + (within >> 2);
      } else {
        mt = 8 * xcd + (li >> 3);
        nt = li & 7;
      }
    } else {
      mt = li / NTN; nt = li % NTN;
    }
    const int m0 = mt * 256, n0 = nt * 128;
    f32x16 acc[4][2];
#pragma unroll
    for (int a = 0; a < 4; a++)
#pragma unroll
      for (int b2 = 0; b2 < 2; b2++)
#pragma unroll
        for (int i = 0; i < 16; i++) acc[a][b2][i] = 0.f;
    {
      const int i_row = lane >> 2;
      const int cl = (lane & 3) ^ ((i_row >> 2) & 3);
      const u16* gA0 = A + toff((size_t)(m0 + 64 * wave + i_row), cl * 8);
      const u16* gB0 = Bt + toff((size_t)(n0 + 32 * wave + i_row), cl * 8);
      const int physx = (r >> 2) & 3;
      const uint32_t lds_base = (uint32_t)(size_t)(LDSP char*)smem;
      auto issue1 = [&](int kt, int buf, int idx) {
        char* st = smem + buf * 24576;
        if (idx < 4) {
          __builtin_amdgcn_global_load_lds((const unsigned*)(gA0 + kt * 64 + idx * 16384),
                                           (LDSP unsigned*)(st + wave * 4096 + idx * 1024), 16, 0, 0);
        } else {
          __builtin_amdgcn_global_load_lds((const unsigned*)(gB0 + kt * 64 + (idx - 4) * 16384),
                                           (LDSP unsigned*)(st + 16384 + wave * 2048 + (idx - 4) * 1024), 16, 0, 0);
        }
      };
      auto issue = [&](int kt, int buf) {
#pragma unroll
        for (int idx = 0; idx < 6; idx++) issue1(kt, buf, idx);
      };
      asm volatile("s_waitcnt vmcnt(0)" ::: "memory");
      issue(0, 0); issue(1, 1);
      int buf = 0;
      for (int kt = 0; kt < 32; kt++) {
        if (kt < 31) asm volatile("s_waitcnt vmcnt(6)" ::: "memory");
        else asm volatile("s_waitcnt vmcnt(0)" ::: "memory");
        RAW_BARRIER();
        int nb2 = buf + 2; if (nb2 >= 3) nb2 -= 3;
        const bool pf = kt + 2 < 32;
        const uint32_t sta = lds_base + (uint32_t)(buf * 24576);
#pragma unroll
        for (int s2 = 0; s2 < 2; s2++) {
          const uint32_t phys = (uint32_t)(((2 * s2 + h) ^ physx) * 16);
          const uint32_t aaddr = sta + (uint32_t)((wm * 128 + r) * 64) + phys;
          const uint32_t baddr = sta + 16384u + (uint32_t)((wn * 64 + r) * 64) + phys;
          bf16x8 a0, a1, a2, a3, b0, b1;
          asm volatile("ds_read_b128 %0, %1" : "=v"(a0) : "v"(aaddr));
          asm volatile("ds_read_b128 %0, %1" : "=v"(b0) : "v"(baddr));
          asm volatile("ds_read_b128 %0, %1 offset:2048" : "=v"(b1) : "v"(baddr));
          asm volatile("ds_read_b128 %0, %1 offset:2048" : "=v"(a1) : "v"(aaddr));
          asm volatile("ds_read_b128 %0, %1 offset:4096" : "=v"(a2) : "v"(aaddr));
          asm volatile("ds_read_b128 %0, %1 offset:6144" : "=v"(a3) : "v"(aaddr));
          asm volatile("s_waitcnt lgkmcnt(3)" : "+v"(a0), "+v"(b0), "+v"(b1));
          __builtin_amdgcn_s_setprio(1);
          acc[0][0] = mfma32(a0, b0, acc[0][0]);
          acc[0][1] = mfma32(a0, b1, acc[0][1]);
          __builtin_amdgcn_sched_barrier(0);
          if (pf) issue1(kt + 2, nb2, 3 * s2 + 0);
          asm volatile("s_waitcnt lgkmcnt(2)" : "+v"(a1));
          acc[1][0] = mfma32(a1, b0, acc[1][0]);
          acc[1][1] = mfma32(a1, b1, acc[1][1]);
          __builtin_amdgcn_sched_barrier(0);
          if (pf) issue1(kt + 2, nb2, 3 * s2 + 1);
          asm volatile("s_waitcnt lgkmcnt(1)" : "+v"(a2));
          acc[2][0] = mfma32(a2, b0, acc[2][0]);
          acc[2][1] = mfma32(a2, b1, acc[2][1]);
          __builtin_amdgcn_sched_barrier(0);
          if (pf) issue1(kt + 2, nb2, 3 * s2 + 2);
          asm volatile("s_waitcnt lgkmcnt(0)" : "+v"(a3));
          acc[3][0] = mfma32(a3, b0, acc[3][0]);
          acc[3][1] = mfma32(a3, b1, acc[3][1]);
          __builtin_amdgcn_s_setprio(0);
          __builtin_amdgcn_sched_barrier(0);
        }
        buf = buf + 1; if (buf >= 3) buf = 0;
      }
      __syncthreads();
    }
    if (MODE == 1) {
#pragma unroll
      for (int mi = 0; mi < 4; mi++)
#pragma unroll
        for (int ni = 0; ni < 2; ni++) {
          const int col = n0 + wn * 64 + ni * 32 + r;
          const float g = p.mod[(size_t)(l * 4 + (m0 >> 12)) * 3072 + 2048 + col];
          const size_t rbase = (size_t)(m0 + wm * 128 + mi * 32 + 4 * h) * 1024 + col;
          float xo[16];
#pragma unroll
          for (int i = 0; i < 16; i++) xo[i] = __builtin_nontemporal_load(xin + rbase + (size_t)((i & 3) + 8 * (i >> 2)) * 1024);
#pragma unroll
          for (int i = 0; i < 16; i++) outp[rbase + (size_t)((i & 3) + 8 * (i >> 2)) * 1024] = xo[i] + g * acc[mi][ni][i];
        }
    } else {
      float* Cw = (float*)smem + wave * (32 * 65);
      const int row = lane & 31, hf = lane >> 5;
#pragma unroll
      for (int mi = 0; mi < 4; mi++) {
#pragma unroll
        for (int ni = 0; ni < 2; ni++)
#pragma unroll
          for (int i = 0; i < 16; i++)
            Cw[((i & 3) + 8 * (i >> 2) + 4 * h) * 65 + ni * 32 + r] = acc[mi][ni][i];
        asm volatile("s_waitcnt lgkmcnt(0)" ::: "memory");
        float v[32];
#pragma unroll
        for (int j = 0; j < 32; j++) v[j] = Cw[row * 65 + hf * 32 + j];
        asm volatile("s_waitcnt lgkmcnt(0)" ::: "memory");
        const int tok = m0 + wm * 128 + mi * 32 + row;
        const int pos = tok & 4095;
        const float* rp = p.rope + (size_t)pos * 72;
        if (n0 < 512) {
          const bool isq = n0 < 256;
          const float* w = (isq ? p.qn_a : p.kn_a) + l * 32;
          const float qs = isq ? 0.17677669529663687f * LOG2E : 1.f;
          float ss = 0.f;
#pragma unroll
          for (int j = 0; j < 32; j++) ss += v[j] * v[j];
          const float rstd = rsqrtf(ss * (1.f / 32.f) + 1e-6f) * qs;
#pragma unroll
          for (int j = 0; j < 32; j++) v[j] = v[j] * rstd * w[j];
#pragma unroll
          for (int j = 0; j < 4; j++) {
            const float cs = rp[2 * j], sn = rp[2 * j + 1];
            const float x1 = v[j], x2 = v[4 + j];
            v[j] = x1 * cs - x2 * sn;
            v[4 + j] = x1 * sn + x2 * cs;
          }
        } else if (n0 >= 1024 && n0 < 1792) {
          const bool isq = n0 < 1408;
          const float* w = (isq ? p.qn_b : p.kn_b) + l * 64 + hf * 32;
          const float qs = isq ? 0.125f * LOG2E : 1.f;
          float ss = 0.f;
#pragma unroll
          for (int j = 0; j < 32; j++) ss += v[j] * v[j];
          ss += xhalf(ss);
          const float rstd = rsqrtf(ss * (1.f / 64.f) + 1e-6f) * qs;
#pragma unroll
          for (int j = 0; j < 32; j++) v[j] = v[j] * rstd * w[j];
          if (hf == 0) {
#pragma unroll
            for (int j = 0; j < 8; j++) {
              const float cs = rp[2 * (4 + j)], sn = rp[2 * (4 + j) + 1];
              const float x1 = v[j], x2 = v[8 + j];
              v[j] = x1 * cs - x2 * sn;
              v[8 + j] = x1 * sn + x2 * cs;
            }
          }
        } else if (n0 >= 2560 && n0 < 3072) {
          const float ksc = n0 >= 2816 ? 0.14433756729740643f : 1.f;
          float xv[16];
#pragma unroll
          for (int k = 0; k < 16; k++) {
            const uint32_t msk = 0u - (uint32_t)hf;
            const uint32_t snd = (__float_as_uint(v[k]) & msk) | (__float_as_uint(v[8 + k]) & ~msk);
            xv[k] = xhalf(__uint_as_float(snd));
          }
          if (hf == 0) {
#pragma unroll
            for (int j = 0; j < 8; j++) {
              const float cs = rp[2 * (12 + j)], sn = rp[2 * (12 + j) + 1];
              const float x1 = v[j], x2 = v[24 + j];
              v[j] = (x1 * cs - x2 * sn) * ksc;
              v[24 + j] = (x1 * sn + x2 * cs) * ksc;
            }
#pragma unroll
            for (int j = 8; j < 24; j++) {
              const float cs = rp[2 * (12 + j)], sn = rp[2 * (12 + j) + 1];
              v[j] = (v[j] * cs - xv[j - 8] * sn) * ksc;
            }
          } else {
#pragma unroll
            for (int k = 0; k < 16; k++) {
              const float cs = rp[2 * (12 + k + 8)], sn = rp[2 * (12 + k + 8) + 1];
              v[k] = (xv[k] * sn + v[k] * cs) * ksc;
            }
          }
        } else if ((n0 >= 768 && n0 < 1024) || (n0 >= 2176 && n0 < 2560) || n0 >= 3456) {
#pragma unroll
          for (int j = 0; j < 32; j++) v[j] = silu_f(v[j]);
        }
        {
          char* Cb = (char*)Cw;
#pragma unroll
          for (int j = 0; j < 4; j++) {
            u32x4 w4 = {pk2(v[8 * j], v[8 * j + 1]), pk2(v[8 * j + 2], v[8 * j + 3]), pk2(v[8 * j + 4], v[8 * j + 5]),
                        pk2(v[8 * j + 6], v[8 * j + 7])};
            *(u32x4*)(Cb + row * 144 + hf * 64 + j * 16) = w4;
          }
          asm volatile("s_waitcnt lgkmcnt(0)" ::: "memory");
          const int rr = lane >> 3, ch = lane & 7;
          u16* dstb = p.pbuf + (size_t)(m0 + wm * 128 + mi * 32 + rr) * NP + n0 + wn * 64 + ch * 8;
#pragma unroll
          for (int ps = 0; ps < 4; ps++) {
            u32x4 w4 = *(const u32x4*)(Cb + (rr + 8 * ps) * 144 + ch * 16);
            *(u32x4*)(dstb + (size_t)(8 * ps) * NP) = w4;
          }
          asm volatile("s_waitcnt lgkmcnt(0)" ::: "memory");
        }
      }
      __syncthreads();
    }
  }
}

template <bool B> struct BoolC { static constexpr bool v = B; };

template <bool SHIFT>
__device__ void attnA_task(const Params& p_in, int l, int task, char* smem) {
  const Params p = opaque_params(p_in);
  const int tid = opaque_tid(), wave = tid >> 6, lane = tid & 63, r = lane & 31, h = lane >> 5;
  const int b = task >> 7, hd = (task >> 5) & 3, qblk = task & 31;
  u16* Ks = (u16*)smem;
  u16* Vs = Ks + 64 * 72;
  const u16* Pb = p.pbuf + (size_t)b * SEQ * NP;
  const int qpos = qblk * 128 + wave * 32 + r;
  bf16x8 qf[2][2];
#pragma unroll
  for (int mp = 0; mp < 2; mp++)
#pragma unroll
    for (int s = 0; s < 2; s++)
      qf[mp][s] = *(const bf16x8*)(Pb + (size_t)qpos * NP + hd * 64 + mp * 32 + s * 16 + h * 8);
  f32x16 O[2][2];
#pragma unroll
  for (int a = 0; a < 2; a++)
#pragma unroll
    for (int c = 0; c < 2; c++)
#pragma unroll
      for (int i = 0; i < 16; i++) O[a][c][i] = 0.f;
  float lsum[2] = {0.f, 0.f};
  float negM[2];
  {
    const float kmax = p.ctab[l * 16 + 10];
#pragma unroll
    for (int mp = 0; mp < 2; mp++) {
      float q2 = 0.f;
#pragma unroll
      for (int s = 0; s < 2; s++)
#pragma unroll
        for (int j = 0; j < 8; j++) {
          float qv = __uint_as_float(((uint32_t)(unsigned short)qf[mp][s][j]) << 16);
          q2 += qv * qv;
        }
      q2 += xhalf(q2);
      negM[mp] = -sqrtf(q2) * kmax;
    }
  }
  bf16x8* Qw = (bf16x8*)(smem + 4 * 64 * 72 * 2) + wave * 256 + lane;
#pragma unroll
  for (int mp = 0; mp < 2; mp++)
#pragma unroll
    for (int s = 0; s < 2; s++) Qw[(mp * 2 + s) * 64] = qf[mp][s];
  const int lrow = tid >> 3, lch = tid & 7;
  u32x4 rk[2], rv[2];
  const u16* gbase = Pb + (size_t)lrow * NP + hd * 64 + lch * 8;
#pragma unroll
  for (int i = 0; i < 2; i++) {
    rk[i] = *(const u32x4*)(gbase + (size_t)(32 * i) * NP + 256);
    rv[i] = *(const u32x4*)(gbase + (size_t)(32 * i) * NP + 512);
  }
#pragma unroll
  for (int i = 0; i < 2; i++) {
    *(u32x4*)(Ks + (lrow + 32 * i) * 72 + lch * 8) = rk[i];
    *(u32x4*)(Vs + (lrow + 32 * i) * 72 + lch * 8) = rv[i];
  }
#pragma unroll
  for (int i = 0; i < 2; i++) {
    rk[i] = *(const u32x4*)(gbase + (size_t)(64 + 32 * i) * NP + 256);
    rv[i] = *(const u32x4*)(gbase + (size_t)(64 + 32 * i) * NP + 512);
  }
  __syncthreads();
  {
  for (int kt = 0; kt < 64; kt++) {
    const u16* Kc = Ks + (kt & 1) * (2 * 64 * 72);
    const u16* Vc = Kc + 64 * 72;
    if (kt + 1 < 64) {
      u16* Kn = Ks + ((kt + 1) & 1) * (2 * 64 * 72);
      u16* Vn = Kn + 64 * 72;
#pragma unroll
      for (int i = 0; i < 2; i++) {
        *(u32x4*)(Kn + (lrow + 32 * i) * 72 + lch * 8) = rk[i];
        *(u32x4*)(Vn + (lrow + 32 * i) * 72 + lch * 8) = rv[i];
      }
    }
    if (kt + 2 < 64) {
#pragma unroll
      for (int i = 0; i < 2; i++) {
        rk[i] = *(const u32x4*)(gbase + (size_t)((kt + 2) * 64 + 32 * i) * NP + 256);
        rv[i] = *(const u32x4*)(gbase + (size_t)((kt + 2) * 64 + 32 * i) * NP + 512);
      }
    }
    auto computeS = [&](int mp, int t2) -> f32x16 {
      f32x16 S;
#pragma unroll
      for (int i = 0; i < 16; i++) S[i] = SHIFT ? negM[mp] : 0.f;
#pragma unroll
      for (int s = 0; s < 2; s++) {
        bf16x8 kf = *(const bf16x8*)(Kc + (t2 * 32 + r) * 72 + mp * 32 + s * 16 + h * 8);
        S = mfma32(kf, qf[mp][s], S);
      }
      return S;
    };
    auto doExp = [&](f32x16& S, int mp) {
      float ps = 0.f;
#pragma unroll
      for (int i = 0; i < 16; i++) {
        float pv = fexp2(S[i]);
        ps += pv;
        S[i] = pv;
      }
      lsum[mp] += ps;
    };
    auto doPV = [&](bf16x8 pf0, bf16x8 pf1, int mp, int t2) {
#pragma unroll
      for (int dt = 0; dt < 2; dt++) {
        bf16x8 v0 = load_vfrag(Vc, 72, t2 * 32, dt * 32, lane);
        O[mp][dt] = mfma32(v0, pf0, O[mp][dt]);
        bf16x8 v1 = load_vfrag(Vc, 72, t2 * 32 + 16, dt * 32, lane);
        O[mp][dt] = mfma32(v1, pf1, O[mp][dt]);
      }
    };
    f32x16 Sa = computeS(0, 0);
    f32x16 Sb = computeS(0, 1);
    __builtin_amdgcn_sched_barrier(0);
    doExp(Sa, 0);
    bf16x8 pa0 = pack_p(Sa, 0), pa1 = pack_p(Sa, 1);
    __builtin_amdgcn_sched_barrier(0);
    doPV(pa0, pa1, 0, 0);
    Sa = computeS(1, 0);
    doExp(Sb, 0);
    bf16x8 pb0 = pack_p(Sb, 0), pb1 = pack_p(Sb, 1);
#pragma unroll
    for (int k = 0; k < 6; k++) {
      __builtin_amdgcn_sched_group_barrier(0x8, 1, 0);
      __builtin_amdgcn_sched_group_barrier(0x2, 7, 0);
    }
    __builtin_amdgcn_sched_barrier(0);
    doPV(pb0, pb1, 0, 1);
    Sb = computeS(1, 1);
    doExp(Sa, 1);
    pa0 = pack_p(Sa, 0); pa1 = pack_p(Sa, 1);
#pragma unroll
    for (int k = 0; k < 6; k++) {
      __builtin_amdgcn_sched_group_barrier(0x8, 1, 0);
      __builtin_amdgcn_sched_group_barrier(0x2, 7, 0);
    }
    __builtin_amdgcn_sched_barrier(0);
    doPV(pa0, pa1, 1, 0);
    doExp(Sb, 1);
    pb0 = pack_p(Sb, 0); pb1 = pack_p(Sb, 1);
#pragma unroll
    for (int k = 0; k < 4; k++) {
      __builtin_amdgcn_sched_group_barrier(0x8, 1, 0);
      __builtin_amdgcn_sched_group_barrier(0x2, 10, 0);
    }
    __builtin_amdgcn_sched_barrier(0);
    doPV(pb0, pb1, 1, 1);
    __builtin_amdgcn_sched_barrier(0);
    RAW_BARRIER();
  }
  }
  const float lam = p.ctab[l * 16 + 0];
  const float one_m_li = p.ctab[l * 16 + 1];
  const float l0 = lsum[0] + xhalf(lsum[0]);
  const float l1 = lsum[1] + xhalf(lsum[1]);
  const float inv0 = 1.f / l0, inv1 = lam / l1;
  float ss = 0.f;
#pragma unroll
  for (int dt = 0; dt < 2; dt++)
#pragma unroll
    for (int i = 0; i < 16; i++) {
      float o = O[0][dt][i] * inv0 - O[1][dt][i] * inv1;
      O[0][dt][i] = o;
      ss += o * o;
    }
  ss += xhalf(ss);
  const float rstd = rsqrtf(ss * (1.f / 64.f) + 1e-6f) * one_m_li;
  const size_t tok = (size_t)b * SEQ + qpos;
#pragma unroll
  for (int dt = 0; dt < 2; dt++)
#pragma unroll
    for (int gq = 0; gq < 4; gq++) {
      const int d0 = dt * 32 + 8 * gq + 4 * h;
      u32x2 gt = *(const u32x2*)(p.pbuf + tok * NP + 768 + hd * 64 + d0);
      f32x4 sb = *(const f32x4*)(p.subln_a + l * 64 + d0);
      float v0 = O[0][dt][4 * gq + 0] * rstd * sb[0] * bf_lo(gt[0]);
      float v1 = O[0][dt][4 * gq + 1] * rstd * sb[1] * bf_hi(gt[0]);
      float v2 = O[0][dt][4 * gq + 2] * rstd * sb[2] * bf_lo(gt[1]);
      float v3 = O[0][dt][4 * gq + 3] * rstd * sb[3] * bf_hi(gt[1]);
      u32x2 o = {pk2(v0, v1), pk2(v2, v3)};
      *(u32x2*)(p.ybuf + toff(tok, hd * 64 + d0)) = o;
    }
}

__device__ __forceinline__ void ret_decays(const Params& p, int l, int hd, float& lgf, float& lgb) {
  lgf = p.ctab[l * 16 + 2 + hd];
  lgb = p.ctab[l * 16 + 6 + hd];
}

__device__ __forceinline__ u32x4 scale_bf8(u32x4 v, float sc) {
  u32x4 o;
#pragma unroll
  for (int j = 0; j < 4; j++) o[j] = pk2(bf_lo(v[j]) * sc, bf_hi(v[j]) * sc);
  return o;
}

__device__ void retS_task(const Params& p_in, int l, int task, char* smem) {
  const Params p = opaque_params(p_in);
  const int tid = opaque_tid(), wave = tid >> 6, lane = tid & 63, r = lane & 31, h = lane >> 5;
  const int b = task >> 7, hd = (task >> 5) & 3, n = task & 31;
  u16* Kf = (u16*)smem;
  u16* Kb = Kf + 128 * 72;
  u16* Vs = Kb + 128 * 72;
  const u16* Pb = p.pbuf + ((size_t)b * SEQ + n * 128) * NP;
  float lgf, lgb;
  ret_decays(p, l, hd, lgf, lgb);
#pragma unroll
  for (int i = 0; i < 4; i++) {
    const int c = tid + 256 * i;
    const int row = c >> 3, ch = c & 7;
    u32x4 kv = *(const u32x4*)(Pb + (size_t)row * NP + 2816 + hd * 64 + ch * 8);
    const float df = fexp2(lgf * (float)(127 - row)), db = fexp2(lgb * (float)row);
    *(u32x4*)(Kf + row * 72 + ch * 8) = scale_bf8(kv, df);
    *(u32x4*)(Kb + row * 72 + ch * 8) = scale_bf8(kv, db);
  }
#pragma unroll
  for (int i = 0; i < 6; i++) {
    const int c = tid + 256 * i;
    const int row = c / 12, ch = c % 12;
    *(u32x4*)(Vs + row * 104 + ch * 8) = *(const u32x4*)(Pb + (size_t)row * NP + 3072 + hd * 96 + ch * 8);
  }
  __syncthreads();
  const int dir = wave >> 1, kkt = wave & 1;
  const u16* Kt = dir ? Kb : Kf;
  f32x16 acc[3];
#pragma unroll
  for (int c = 0; c < 3; c++)
#pragma unroll
    for (int i = 0; i < 16; i++) acc[c][i] = 0.f;
#pragma unroll
  for (int s = 0; s < 8; s++) {
    bf16x8 kfr = load_vfrag(Kt, 72, 16 * s, 32 * kkt, lane);
#pragma unroll
    for (int dt = 0; dt < 3; dt++) {
      bf16x8 vfr = load_vfrag(Vs, 104, 16 * s, 32 * dt, lane);
      acc[dt] = mfma32(vfr, kfr, acc[dt]);
    }
  }
  float* dst = p.state + ((((size_t)(b * 4 + hd) * 32 + n) * 2 + dir) * 4608);
  const int kk = 32 * kkt + r;
  if (kk < 48) {
#pragma unroll
    for (int dt = 0; dt < 3; dt++)
#pragma unroll
      for (int i = 0; i < 16; i++) {
        const int d = 32 * dt + (i & 3) + 8 * (i >> 2) + 4 * h;
        store_wt_f32(dst + d * 48 + kk, acc[dt][i]);
      }
  }
}

__device__ void retO_task(const Params& p_in, int l, int task, char* smem) {
  const Params p = opaque_params(p_in);
  const int tid = opaque_tid(), wave = tid >> 6, lane = tid & 63, r = lane & 31, h = lane >> 5;
  const int b = task >> 7, hd = (task >> 5) & 3, qblk = task & 31;
  u16* Ks = (u16*)smem;
  u16* Vs = Ks + 64 * 72;
  u16* RfT = Vs + 64 * 104;
  u16* RbT = RfT + 96 * 72;
  const u16* Pb = p.pbuf + (size_t)b * SEQ * NP;
  const int qpos = qblk * 128 + wave * 32 + r;
  float lgf, lgb;
  ret_decays(p, l, hd, lgf, lgb);
  const float nlgb = -lgb;
  {
    const u16* Pf = (const u16*)(p.state + (size_t)16 * 32 * 2 * 4608) + (((size_t)(b * 4 + hd) * 32 + qblk) * 2) * 4608;
#pragma unroll
    for (int j = 0; j < 3; j++) {
      const int c = tid + 256 * j;
      if (c < 576) {
        const int e = 8 * c;
        const int d = e / 48, kk = e % 48;
        *(u32x4*)(RfT + d * 72 + kk) = *(const u32x4*)(Pf + e);
        *(u32x4*)(RbT + d * 72 + kk) = *(const u32x4*)(Pf + 4608 + e);
      }
    }
  }
  bf16x8 qf[3];
#pragma unroll
  for (int s = 0; s < 3; s++) qf[s] = *(const bf16x8*)(Pb + (size_t)qpos * NP + 2560 + hd * 64 + s * 16 + h * 8);
  f32x16 O[3];
  __syncthreads();
  {
    const int iq = wave * 32 + r;
    const float sf = fexp2(lgf * (float)(iq + 1)), sb = fexp2(lgb * (float)(128 - iq));
#pragma unroll
    for (int dt = 0; dt < 3; dt++) {
      f32x16 X;
#pragma unroll
      for (int i = 0; i < 16; i++) X[i] = 0.f;
#pragma unroll
      for (int s = 0; s < 3; s++) {
        bf16x8 a = *(const bf16x8*)(RfT + (32 * dt + r) * 72 + 16 * s + 8 * h);
        X = mfma32(a, qf[s], X);
      }
#pragma unroll
      for (int i = 0; i < 16; i++) O[dt][i] = X[i] * sf;
#pragma unroll
      for (int i = 0; i < 16; i++) X[i] = 0.f;
#pragma unroll
      for (int s = 0; s < 3; s++) {
        bf16x8 a = *(const bf16x8*)(RbT + (32 * dt + r) * 72 + 16 * s + 8 * h);
        X = mfma32(a, qf[s], X);
      }
#pragma unroll
      for (int i = 0; i < 16; i++) O[dt][i] += X[i] * sb;
    }
  }
  const int krow = tid >> 3, kch = tid & 7;
  u32x4 rk[2], rv[3];
  int vrow[3], vch[3];
#pragma unroll
  for (int i = 0; i < 3; i++) {
    int c = tid + 256 * i;
    vrow[i] = c / 12;
    vch[i] = c % 12;
  }
  const u16* kbase = Pb + (size_t)krow * NP + 2816 + hd * 64 + kch * 8;
  const u16* vbase = Pb + 3072 + hd * 96;
  const int kt0 = 2 * qblk;
#pragma unroll
  for (int i = 0; i < 2; i++) rk[i] = *(const u32x4*)(kbase + (size_t)(kt0 * 64 + 32 * i) * NP);
#pragma unroll
  for (int i = 0; i < 3; i++) rv[i] = *(const u32x4*)(vbase + (size_t)(kt0 * 64 + vrow[i]) * NP + vch[i] * 8);
  for (int kt = kt0; kt < kt0 + 2; kt++) {
    __syncthreads();
#pragma unroll
    for (int i = 0; i < 2; i++) *(u32x4*)(Ks + (krow + 32 * i) * 72 + kch * 8) = rk[i];
#pragma unroll
    for (int i = 0; i < 3; i++) *(u32x4*)(Vs + vrow[i] * 104 + vch[i] * 8) = rv[i];
    __syncthreads();
    if (kt + 1 < kt0 + 2) {
#pragma unroll
      for (int i = 0; i < 2; i++) rk[i] = *(const u32x4*)(kbase + (size_t)((kt + 1) * 64 + 32 * i) * NP);
#pragma unroll
      for (int i = 0; i < 3; i++) rv[i] = *(const u32x4*)(vbase + (size_t)((kt + 1) * 64 + vrow[i]) * NP + vch[i] * 8);
    }
    bf16x8 pf[2][2];
#pragma unroll
    for (int t2 = 0; t2 < 2; t2++) {
      f32x16 S;
#pragma unroll
      for (int i = 0; i < 16; i++) S[i] = 0.f;
#pragma unroll
      for (int s = 0; s < 3; s++) {
        bf16x8 kf = *(const bf16x8*)(Ks + (t2 * 32 + r) * 72 + s * 16 + h * 8);
        S = mfma32(kf, qf[s], S);
      }
      const int kp0 = kt * 64 + t2 * 32 + 4 * h;
#pragma unroll
      for (int i = 0; i < 16; i++) {
        const int kp = kp0 + (i & 3) + 8 * (i >> 2);
        const float delta = (float)(qpos - kp);
        const float e = delta * (delta >= 0.f ? lgf : nlgb);
        S[i] = S[i] * fexp2(e);
      }
      pf[t2][0] = pack_p(S, 0);
      pf[t2][1] = pack_p(S, 1);
    }
#pragma unroll
    for (int t2 = 0; t2 < 2; t2++)
#pragma unroll
      for (int s2 = 0; s2 < 2; s2++)
#pragma unroll
        for (int dt = 0; dt < 3; dt++) {
          bf16x8 vf = load_vfrag(Vs, 104, t2 * 32 + s2 * 16, dt * 32, lane);
          O[dt] = mfma32(vf, pf[t2][s2], O[dt]);
        }
  }
  float ss = 0.f;
#pragma unroll
  for (int dt = 0; dt < 3; dt++)
#pragma unroll
    for (int i = 0; i < 16; i++) ss += O[dt][i] * O[dt][i];
  ss += xhalf(ss);
  const float rstd = rsqrtf(ss * (1.f / 96.f) + 1e-6f);
  const size_t tok = (size_t)b * SEQ + qpos;
#pragma unroll
  for (int dt = 0; dt < 3; dt++)
#pragma unroll
    for (int gq = 0; gq < 4; gq++) {
      const int d0 = dt * 32 + 8 * gq + 4 * h;
      u32x2 gt = *(const u32x2*)(p.pbuf + tok * NP + 3456 + hd * 96 + d0);
      f32x4 gn = *(const f32x4*)(p.gn_c + l * 96 + d0);
      float v0 = O[dt][4 * gq + 0] * rstd * gn[0] * bf_lo(gt[0]);
      float v1 = O[dt][4 * gq + 1] * rstd * gn[1] * bf_hi(gt[0]);
      float v2 = O[dt][4 * gq + 2] * rstd * gn[2] * bf_lo(gt[1]);
      float v3 = O[dt][4 * gq + 3] * rstd * gn[3] * bf_hi(gt[1]);
      u32x2 o = {pk2(v0, v1), pk2(v2, v3)};
      *(u32x2*)(p.ybuf + toff(tok, 640 + hd * 96 + d0)) = o;
    }
}


__device__ void retScan_task(const Params& p_in, int l, int task) {
  const Params p = opaque_params(p_in);
  const int tid = opaque_tid();
  const int half = task & 1, dir = (task >> 1) & 1, pair = task >> 2, hd = pair & 3;
  float lgf, lgb;
  ret_decays(p, l, hd, lgf, lgb);
  const float w = fexp2((dir ? lgb : lgf) * 128.f);
  const float* Sbase = p.state + ((size_t)pair * 32) * 2 * 4608 + (size_t)dir * 4608 + (size_t)half * 2304;
  u16* Pf = (u16*)(p.state + (size_t)16 * 32 * 2 * 4608) + ((size_t)pair * 32) * 2 * 4608 + (size_t)dir * 4608 + (size_t)half * 2304;
  const bool tail = tid < 64;
  f32x4 acc[3];
#pragma unroll
  for (int j = 0; j < 3; j++) acc[j] = (f32x4){0.f, 0.f, 0.f, 0.f};
#pragma unroll 8
  for (int i = 0; i < 32; i++) {
    const int m = dir ? 31 - i : i;
    const f32x4* src = (const f32x4*)(Sbase + (size_t)m * 2 * 4608) + tid;
    u16* dstp = Pf + (size_t)m * 2 * 4608;
#pragma unroll
    for (int j = 0; j < 3; j++) {
      if (j < 2 || tail) {
        f32x4 v = src[256 * j];
        u32x2 x = {pk2(acc[j][0], acc[j][1]), pk2(acc[j][2], acc[j][3])};
        *(u32x2*)(dstp + 4 * (tid + 256 * j)) = x;
        acc[j] = acc[j] * w + v;
      }
    }
  }
}

__device__ __forceinline__ void event_signal(unsigned* cnt) {
  asm volatile("s_waitcnt vmcnt(0)" ::: "memory");
  __syncthreads();
  if (opaque_tid() == 0) {
    (void)__hip_atomic_fetch_add(cnt, 1u, __ATOMIC_RELAXED, __HIP_MEMORY_SCOPE_AGENT);
  }
}
__device__ __forceinline__ void event_wait(unsigned* cnt, unsigned target) {
  if (opaque_tid() == 0) {
    unsigned sp = 0;
    while (__hip_atomic_load(cnt, __ATOMIC_RELAXED, __HIP_MEMORY_SCOPE_AGENT) < target) {
      __builtin_amdgcn_s_sleep(1);
      if (++sp > (1u << 24)) break;
    }
    __builtin_amdgcn_fence(__ATOMIC_ACQUIRE, "agent");
    asm volatile("s_waitcnt vmcnt(0)" ::: "memory");
  }
  __syncthreads();
}

__device__ void attnB_task(const Params& p_in, int l, int task, char* smem) {
  const Params p = opaque_params(p_in);
  const int tid = opaque_tid(), wave = tid >> 6, lane = tid & 63, r = lane & 31, h = lane >> 5;
  const int tblk = task & 1, r16 = (task >> 1) & 15, bh = task >> 5;
  const int b = bh / 6, hd = bh % 6;
  const u16* Pb = p.pbuf + (size_t)b * SEQ * NP;
  const int t0 = tblk * 128 + wave * 32;
  const int pos0 = r16 + 16 * t0;
  const int qpos = pos0 + 16 * r;
  bf16x8 qf[4];
#pragma unroll
  for (int s = 0; s < 4; s++) qf[s] = *(const bf16x8*)(Pb + (size_t)qpos * NP + 1024 + hd * 64 + s * 16 + h * 8);
  f32x16 O[2];
#pragma unroll
  for (int c = 0; c < 2; c++)
#pragma unroll
    for (int i = 0; i < 16; i++) O[c][i] = 0.f;
  float lsum = 0.f;
  float negM;
  {
    float q2 = 0.f;
#pragma unroll
    for (int s = 0; s < 4; s++)
#pragma unroll
      for (int j = 0; j < 8; j++) {
        float qv = __uint_as_float(((uint32_t)(unsigned short)qf[s][j]) << 16);
        q2 += qv * qv;
      }
    q2 += xhalf(q2);
    negM = -sqrtf(q2) * p.ctab[l * 16 + 11];
  }
  bf16x8 kf0[4], kf1[4];
  u32x4 rv0[4], rv1[4];
  auto unit_geom = [&](int u, int& g, int& lo) {
    int uu;
    if (u < 20) { g = 1; uu = u; }
    else if (u < 28) { g = 4; uu = u - 20; }
    else { g = 16; uu = u - 28; }
    lo = pos0 - 64 * g + g * 32 * uu;
  };
  auto prefetch = [&](int u, bf16x8 (&kf)[4], u32x4 (&rv)[4]) {
    int g, lo;
    unit_geom(u, g, lo);
    int kp = lo + g * r;
    kp = kp < 0 ? 0 : (kp > SEQ - 1 ? SEQ - 1 : kp);
    const u16* kb = Pb + (size_t)kp * NP + 1408 + hd * 64 + h * 8;
#pragma unroll
    for (int s = 0; s < 4; s++) kf[s] = *(const bf16x8*)(kb + s * 16);
#pragma unroll
    for (int i = 0; i < 4; i++) {
      int c = lane + 64 * i;
      int row = c >> 3, ch = c & 7;
      int vp = lo + g * row;
      vp = vp < 0 ? 0 : (vp > SEQ - 1 ? SEQ - 1 : vp);
      rv[i] = *(const u32x4*)(Pb + (size_t)vp * NP + 1792 + hd * 64 + ch * 8);
    }
  };
  auto body = [&](int u, bf16x8 (&kf)[4], u32x4 (&rv)[4], u16* Vb) {
    int g, lo;
    unit_geom(u, g, lo);
#pragma unroll
    for (int i = 0; i < 4; i++) {
      int c = lane + 64 * i;
      *(u32x4*)(Vb + (c >> 3) * 72 + (c & 7) * 8) = rv[i];
    }
    f32x16 S;
#pragma unroll
    for (int i = 0; i < 16; i++) S[i] = negM;
#pragma unroll
    for (int s = 0; s < 4; s++) S = mfma32(kf[s], qf[s], S);
    if (u + 2 < 33) prefetch(u + 2, kf, rv);
    const int W = 64 * g;
    const int lob = qpos - W > 0 ? qpos - W : 0;
    const int hib = qpos + W < SEQ - 1 ? qpos + W : SEQ - 1;
    const unsigned rng = (unsigned)(hib - lob);
    const int base = lo + 4 * g * h - lob;
    float ps = 0.f;
#pragma unroll
    for (int i = 0; i < 16; i++) {
      const bool valid = (unsigned)(base + g * ((i & 3) + 8 * (i >> 2))) <= rng;
      float pv = valid ? fexp2(S[i]) : 0.f;
      ps += pv;
      S[i] = pv;
    }
    lsum += ps;
    bf16x8 pf0 = pack_p(S, 0), pf1 = pack_p(S, 1);
    asm volatile("s_waitcnt lgkmcnt(0)" ::: "memory");
#pragma unroll
    for (int dt = 0; dt < 2; dt++) {
      bf16x8 v0 = load_vfrag(Vb, 72, 0, dt * 32, lane);
      O[dt] = mfma32(v0, pf0, O[dt]);
      bf16x8 v1 = load_vfrag(Vb, 72, 16, dt * 32, lane);
      O[dt] = mfma32(v1, pf1, O[dt]);
    }
  };
  u16* Vw0 = (u16*)smem + wave * 2 * 32 * 72;
  u16* Vw1 = Vw0 + 32 * 72;
  prefetch(0, kf0, rv0);
  prefetch(1, kf1, rv1);
  for (int u = 0; u < 33; u += 2) {
    body(u, kf0, rv0, Vw0);
    if (u + 1 < 33) body(u + 1, kf1, rv1, Vw1);
  }
  const float lt = lsum + xhalf(lsum);
  const float inv = 1.f / lt;
  const size_t tok = (size_t)b * SEQ + qpos;
#pragma unroll
  for (int dt = 0; dt < 2; dt++)
#pragma unroll
    for (int gq = 0; gq < 4; gq++) {
      const int d0 = dt * 32 + 8 * gq + 4 * h;
      u32x2 gt = *(const u32x2*)(p.pbuf + tok * NP + 2176 + hd * 64 + d0);
      float v0 = O[dt][4 * gq + 0] * inv * bf_lo(gt[0]);
      float v1 = O[dt][4 * gq + 1] * inv * bf_hi(gt[0]);
      float v2 = O[dt][4 * gq + 2] * inv * bf_lo(gt[1]);
      float v3 = O[dt][4 * gq + 3] * inv * bf_hi(gt[1]);
      u32x2 o = {pk2(v0, v1), pk2(v2, v3)};
      *(u32x2*)(p.ybuf + toff(tok, 256 + hd * 64 + d0)) = o;
    }
}

__device__ void phase_mix(const Params& p, int l, char* smem, int bid, int nb) {
  unsigned* ev = p.bar + 0;
  const bool xs = (opq(nb) & 7) == 0;
  const int xcd = xs ? (bid & 7) : 0, jl = xs ? (bid >> 3) : bid, nj = xs ? (nb >> 3) : nb;
  const int nS = xs ? 64 : 512, nB = xs ? 96 : 768;
  const bool noshiftA = p.ctab[l * 16 + 12] <= 64.f;
  for (int li = jl; li < nS; li += nj) { retS_task(p, l, xcd * nS + li, smem); event_signal(ev); __syncthreads(); }
  unsigned* ev2 = p.bar + 64;
  {
    const int nscan = xs ? 8 : 64;
    const int first = nj - nscan;
    if (jl >= first && jl - first < nscan) {
      event_wait(ev, 512u * (unsigned)(l + 1));
      retScan_task(p, l, xcd * nscan + (jl - first));
      asm volatile("s_waitcnt vmcnt(0)" ::: "memory");
      __syncthreads();
      if (opaque_tid() == 0) {
        __builtin_amdgcn_fence(__ATOMIC_RELEASE, "agent");
        asm volatile("s_waitcnt vmcnt(0)" ::: "memory");
        (void)__hip_atomic_fetch_add(ev2, 1u, __ATOMIC_RELAXED, __HIP_MEMORY_SCOPE_AGENT);
      }
      __syncthreads();
    }
  }
  for (int li = jl; li < nS; li += nj) {
    for (int rep = 0; rep < opq(REP_A); rep++) {
      if (noshiftA) attnA_task<false>(p, l, xcd * nS + li, smem); else attnA_task<true>(p, l, xcd * nS + li, smem);
      __syncthreads();
    }
  }
  for (int li = jl; li < nB; li += nj) {
    for (int rep = 0; rep < opq(REP_B); rep++) { attnB_task(p, l, xcd * nB + li, smem); __syncthreads(); }
  }
  event_wait(ev2, 64u * (unsigned)(l + 1));
  for (int li = jl; li < nS; li += nj) {
    for (int rep = 0; rep < opq(REP_C); rep++) { retO_task(p, l, xcd * nS + li, smem); __syncthreads(); }
  }
}

#define XB_TMO      128
#define XB_XCNT(j)  (256  + 64 * (j))
#define XB_XSUB(j)  (1280 + 64 * (j))
#define XB_XGEN(j)  (2304 + 64 * (j))
#define XB_TOP      3328
#define XB_TOPGEN   3392
#define XCD_BAR_WORDS 3456
#define XB_SPIN_CAP (1u << 22)
#define LAS __attribute__((address_space(3)))
__device__ __forceinline__ unsigned xb_ld(unsigned* p) { return __hip_atomic_load(p, __ATOMIC_RELAXED, __HIP_MEMORY_SCOPE_AGENT); }
__device__ __forceinline__ unsigned xb_add(unsigned* p, unsigned v) { return __hip_atomic_fetch_add(p, v, __ATOMIC_RELAXED, __HIP_MEMORY_SCOPE_AGENT); }
__device__ __forceinline__ unsigned xb_xcc_id() { return (unsigned)__builtin_amdgcn_s_getreg((3 << 11) | 20) & 0xFu; }
#define XB_SPIN(cond, bar) do { unsigned _sp = 0; while (cond) { __builtin_amdgcn_s_sleep(1); \
    if ((++_sp & 255u) == 0u) { if (xb_ld(&(bar)[XB_TMO])) break; if (_sp > XB_SPIN_CAP) { atomicAdd(&(bar)[XB_TMO], 1u); break; } } } } while (0)
struct XcdBarrier { unsigned* bar; unsigned x; volatile LAS unsigned* st; };
__device__ __forceinline__ XcdBarrier xcd_barrier_post(unsigned* bar, volatile LAS unsigned* st) {
  XcdBarrier b; b.bar = bar; b.x = xb_xcc_id(); b.st = st;
  if (opaque_tid() == 0) (void)xb_add(&bar[XB_XCNT(b.x)], 1u);
  return b;
}
__device__ __forceinline__ void xcd_barrier_complete(unsigned* bar, unsigned x, unsigned& nloc, unsigned& nx) {
  const unsigned G = gridDim.x * gridDim.y * gridDim.z;
  unsigned sum, cnt, mine, sp = 0u;
  for (;;) {
    sum = 0u; cnt = 0u; mine = 0u;
#pragma unroll
    for (unsigned j = 0; j < 16; ++j) { const unsigned c = xb_ld(&bar[XB_XCNT(j)]); sum += c; cnt += (c > 0u) ? 1u : 0u; mine = (j == x) ? c : mine; }
    if (sum == G) break;
    __builtin_amdgcn_s_sleep(1);
    if ((++sp & 255u) == 0u) { if (xb_ld(&bar[XB_TMO])) break; if (sp > XB_SPIN_CAP) { atomicAdd(&bar[XB_TMO], 1u); break; } }
  }
  nloc = mine > 0u ? mine : 1u; nx = cnt > 0u ? cnt : 1u;
}
__device__ __forceinline__ void xcd_barrier(const XcdBarrier& b) {
  asm volatile("s_waitcnt vmcnt(0)" ::: "memory");
  __syncthreads();
  if (opaque_tid() == 0) {
    unsigned* bar = b.bar;
    __builtin_amdgcn_s_waitcnt(0);
    unsigned nloc = b.st[0], nx = b.st[1];
    if (nloc == 0u) { xcd_barrier_complete(bar, b.x, nloc, nx); b.st[0] = nloc; b.st[1] = nx; }
    const unsigned old = xb_add(&bar[XB_XSUB(b.x)], 1u);
    const unsigned gen = old / nloc;
    if (old + 1u == (gen + 1u) * nloc) {
      __builtin_amdgcn_fence(__ATOMIC_RELEASE, "agent");
      asm volatile("s_waitcnt vmcnt(0)" ::: "memory");
      const unsigned og = xb_add(&bar[XB_TOP], 1u);
      const unsigned tg = og / nx;
      if (og + 1u == (tg + 1u) * nx) xb_add(&bar[XB_TOPGEN], 1u);
      else XB_SPIN(xb_ld(&bar[XB_TOPGEN]) == tg, bar);
      __builtin_amdgcn_fence(__ATOMIC_ACQUIRE, "agent");
      xb_add(&bar[XB_XGEN(b.x)], 1u);
      asm volatile("s_waitcnt vmcnt(0)" ::: "memory");
    } else {
      XB_SPIN(xb_ld(&bar[XB_XGEN(b.x)]) == gen, bar);
      __builtin_amdgcn_fence(__ATOMIC_ACQUIRE, "agent");
      asm volatile("s_waitcnt vmcnt(0)" ::: "memory");
    }
  }
  __syncthreads();
}

#if USE_COOP
__global__ void __launch_bounds__(256, 2) mega(Params p, int ph_lo, int ph_hi, int coop) {
  __shared__ __attribute__((aligned(16))) char smem[SMEM_BYTES];
  __shared__ uint4 xb_words;
  const int bid = blockIdx.x, nb = gridDim.x;
  if (threadIdx.x == 0) xb_words = make_uint4(0u, 0u, 0u, 0u);
  __syncthreads();
  if (coop) (void)xcd_barrier_post(p.bar, (volatile LAS unsigned*)&xb_words);
  if (ph_hi > 1000) cg::this_grid().sync();
  for (int ph = ph_lo; ph < ph_hi; ph++) {
    if (ph == 0) { for (int rep = 0; rep < opq(REP_P0); rep++) phase0(p, smem, bid, nb); }
    else if (ph == 1) phase0b(p, bid, nb);
    else {
      const int l = (ph - 2) >> 2, sub = (ph - 2) & 3;
      const float* xin = l == 0 ? p.x : p.out;
      if (sub == 0) { for (int rep = 0; rep < opq(REP_N); rep++) phase_norm(p, l, xin, bid, nb); }
      else if (sub == 1) { for (int rep = 0; rep < opq(REP_G0); rep++) phase_gemm<0>(p, l, xin, p.out, smem, bid, nb); }
      else if (sub == 2) phase_mix(p, l, smem, bid, nb);
      else {
        for (int rep = 1; rep < opq(REP_G1); rep++) phase_gemm<1>(p, l, xin, (float*)p.pbuf, smem, bid, nb);
        phase_gemm<1>(p, l, xin, p.out, smem, bid, nb);
      }
    }
    if (coop && ph + 1 < ph_hi) {
      XcdBarrier xb;
      xb.bar = p.bar; xb.x = xb_xcc_id(); xb.st = (volatile LAS unsigned*)&xb_words;
      xcd_barrier(xb);
    }
  }
}
#else
__global__ void __launch_bounds__(256, 2) k_phase0(Params p) {
  __shared__ __attribute__((aligned(16))) char smem[SMEM_BYTES];
  phase0(p, smem, blockIdx.x, gridDim.x);
}
__global__ void __launch_bounds__(256, 2) k_phase0b(Params p) { phase0b(p, blockIdx.x, gridDim.x); }
__global__ void __launch_bounds__(256, 2) k_norm(Params p, int l) {
  phase_norm(p, l, l == 0 ? p.x : p.out, blockIdx.x, gridDim.x);
}
template <int MODE>
__global__ void __launch_bounds__(256, 2) k_gemm(Params p, int l) {
  __shared__ __attribute__((aligned(16))) char smem[SMEM_BYTES];
  phase_gemm<MODE>(p, l, l == 0 ? p.x : p.out, p.out, smem, blockIdx.x, gridDim.x);
}
template <int WHICH>
__global__ void __launch_bounds__(256, WHICH == 0 ? 1 : 2) k_mix(Params p, int l) {
  __shared__ __attribute__((aligned(16))) char smem[SMEM_BYTES];
  if (WHICH == 0) { for (int t = blockIdx.x; t < 512; t += gridDim.x) { attnA_task<true>(p, l, t, smem); __syncthreads(); } }
  if (WHICH == 1) { for (int t = blockIdx.x; t < 512; t += gridDim.x) { retS_task(p, l, t, smem); __syncthreads(); } }
  if (WHICH == 3) { for (int t = blockIdx.x; t < 512; t += gridDim.x) { retO_task(p, l, t, smem); __syncthreads(); } }
  if (WHICH == 2) { for (int t = blockIdx.x; t < 768; t += gridDim.x) { attnB_task(p, l, t, smem); __syncthreads(); } }
}
#endif

extern "C" void kernel_launch(void* const* d_in, const int* in_sizes, int n_in, void* d_out, int out_size,
                              void* d_ws, size_t ws_size, hipStream_t stream) {
  Params p{};
  p.x = (const float*)d_in[0]; p.c = (const float*)d_in[1]; p.norm_g = (const float*)d_in[2];
  p.w_ada = (const float*)d_in[3]; p.b_ada = (const float*)d_in[4]; p.w_in = (const float*)d_in[5];
  p.w_out = (const float*)d_in[6]; p.qn_a = (const float*)d_in[7]; p.kn_a = (const float*)d_in[8];
  p.lq1 = (const float*)d_in[9]; p.lk1 = (const float*)d_in[10]; p.lq2 = (const float*)d_in[11];
  p.lk2 = (const float*)d_in[12]; p.subln_a = (const float*)d_in[13]; p.qn_b = (const float*)d_in[14];
  p.kn_b = (const float*)d_in[15]; p.ret_decay = (const float*)d_in[16]; p.gn_c = (const float*)d_in[17];
  p.out = (float*)d_out;
  char* ws = (char*)d_ws;
  size_t off = 0;
  auto take = [&](size_t bytes) { char* q = ws + off; off += (bytes + 255) & ~(size_t)255; return q; };
  p.wt_in = (u16*)take((size_t)4 * NP * 1024 * 2);
  p.wt_out = (u16*)take((size_t)4 * 1024 * 1024 * 2);
  p.hbuf = (u16*)take((size_t)NTOK * 1024 * 2);
  p.pbuf = (u16*)take((size_t)NTOK * NP * 2);
  p.ybuf = (u16*)take((size_t)NTOK * 1024 * 2);
  p.modp = (float*)take((size_t)16 * 49152 * 4);
  p.mod = (float*)take((size_t)49152 * 4);
  p.rope = (float*)take((size_t)4096 * 72 * 4);
  p.bar = (unsigned*)take((size_t)XCD_BAR_WORDS * 4);
  p.ctab = (float*)take(64 * 4);
  p.state = (float*)p.hbuf;

#if USE_COOP
  static int grid_blocks = 0;
  if (!grid_blocks) {
    int dev = 0, cus = 0, per_cu = 0;
    (void)hipGetDevice(&dev);
    (void)hipDeviceGetAttribute(&cus, hipDeviceAttributeMultiprocessorCount, dev);
    (void)hipOccupancyMaxActiveBlocksPerMultiprocessor(&per_cu, mega, 256, 0);
    if (per_cu < 1) per_cu = 1;
    if (per_cu > 2) per_cu = 2;
    grid_blocks = cus * per_cu;
  }
  (void)hipMemsetAsync(p.bar, 0, (size_t)XCD_BAR_WORDS * 4, stream);
  int lo = 0, hi = 18, coop = 1;
  void* args[] = {&p, &lo, &hi, &coop};
  hipError_t e = hipLaunchCooperativeKernel((void*)mega, dim3(grid_blocks), dim3(256), args, 0, stream);
  if (e != hipSuccess) fprintf(stderr, "cooperative launch failed: %s (grid %d)\n", hipGetErrorString(e), grid_blocks);
#else
  const int G = 512;
  k_phase0<<<G, 256, 0, stream>>>(p);
  k_phase0b<<<G, 256, 0, stream>>>(p);
  for (int l = 0; l < 4; l++) {
    k_norm<<<G, 256, 0, stream>>>(p, l);
    k_gemm<0><<<G, 256, 0, stream>>>(p, l);
    k_mix<0><<<G, 256, 0, stream>>>(p, l);
    k_mix<1><<<G, 256, 0, stream>>>(p, l);
    k_mix<3><<<G, 256, 0, stream>>>(p, l);
    k_mix<2><<<G, 256, 0, stream>>>(p, l);
    k_gemm<1><<<G, 256, 0, stream>>>(p, l);
  }
#endif
}
```
